# Optimizing an MI355X kernel written in HIP

```python
import jax, jax.numpy as jnp
from jax import lax
import numpy as np

D_MODEL = 2048
BATCH = 2
SEQ = 8192
DEPTH = 1

N_HEADS_MLA = 8
Q_LORA = 512
KV_LORA = 256
MLA_NOPE = 128
MLA_ROPE = 64
MLA_V = 128
MLA_QK = MLA_NOPE + MLA_ROPE
DIL_GROUPS = ((128, 1), (512, 4), (2048, 16))
N_DIL_GROUPS = len(DIL_GROUPS)
N_HEADS_DIL = 8
DIL_HEAD = 128
DIL_ROT = DIL_HEAD // 4
ROPE_THETA = 500000.0
D_FF = 5632
PLE_DIM = 256
EPS = 1e-6
Q_BLOCK = 128
NEG = -1e30

OFF_CQ = 0
OFF_CKV = OFF_CQ + Q_LORA
OFF_KR = OFF_CKV + KV_LORA
OFF_DIL = OFF_KR + MLA_ROPE
DIL_QKV = N_DIL_GROUPS * 3 * N_HEADS_DIL * DIL_HEAD
OFF_GATE = OFF_DIL + DIL_QKV
N_BRANCH = 2
D_IN = OFF_GATE + N_BRANCH * D_MODEL

kernel_name = "hybrid_mla_dilated_gated_macaron"


def rmsnorm(x, g):
    xf = x.astype(jnp.float32)
    y = xf * lax.rsqrt(jnp.mean(xf * xf, axis=-1, keepdims=True) + EPS)
    return (y * g.astype(jnp.float32)).astype(x.dtype)


def rope(x, pos):
    rd = x.shape[-1]
    half = rd // 2
    inv = ROPE_THETA ** (-jnp.arange(half, dtype=jnp.float32) * 2.0 / rd)
    ang = pos.astype(jnp.float32)[..., None] * inv
    cos = jnp.cos(ang)[:, :, None, :]
    sin = jnp.sin(ang)[:, :, None, :]
    xf = x.astype(jnp.float32)
    x1, x2 = xf[..., :half], xf[..., half:]
    return jnp.concatenate([x1 * cos - x2 * sin, x2 * cos + x1 * sin], axis=-1).astype(x.dtype)


def swiglu(h, wg, wu, wd):
    return (jax.nn.silu(h @ wg) * (h @ wu)) @ wd


def causal_block_attention(q, k, v):
    B, S, H, Dq = q.shape
    nq = S // Q_BLOCK
    qb = q.reshape(B, nq, Q_BLOCK, H, Dq).transpose(1, 0, 2, 3, 4)
    starts = jnp.arange(nq, dtype=jnp.int32) * Q_BLOCK
    kpos = jnp.arange(S, dtype=jnp.int32)

    def one_block(args):
        qi, s0 = args
        sc = jnp.einsum('bqhd,bkhd->bhqk', qi, k).astype(jnp.float32)
        qpos = s0 + jnp.arange(Q_BLOCK, dtype=jnp.int32)
        mask = kpos[None, :] <= qpos[:, None]
        pr = jax.nn.softmax(jnp.where(mask[None, None], sc, NEG), axis=-1)
        return jnp.einsum('bhqk,bkhd->bqhd', pr.astype(v.dtype), v)

    out = lax.map(one_block, (qb, starts))
    return out.transpose(1, 0, 2, 3, 4).reshape(B, S, H, v.shape[-1])


def dilated_window_attention(q, k, v, dil, n):
    B, S, H, Dh = q.shape
    L = S // dil
    Lp = -(-L // n) * n
    nb = Lp // n

    def phase_major(t):
        t = t.reshape(B, L, dil, H, Dh).transpose(0, 2, 1, 3, 4)
        return jnp.pad(t, ((0, 0), (0, 0), (0, Lp - L), (0, 0), (0, 0)))

    def windows(t):
        t = jnp.pad(phase_major(t), ((0, 0), (0, 0), (n, 0), (0, 0), (0, 0)))
        t = t.reshape(B, dil, nb + 1, n, H, Dh)
        return jnp.concatenate([t[:, :, :-1], t[:, :, 1:]], axis=3)

    qb = phase_major(q).reshape(B, dil, nb, n, H, Dh)
    kw = windows(k)
    vw = windows(v)
    sc = jnp.einsum('brnqhc,brnkhc->brnhqk', qb, kw).astype(jnp.float32)
    i = jnp.arange(n)[:, None]
    j = jnp.arange(2 * n)[None, :]
    dist = i + n - j
    band = (dist >= 0) & (dist <= n)
    keyok = ((jnp.arange(nb)[:, None] - 1) * n + jnp.arange(2 * n)[None, :]) >= 0
    valid = (band[None] & keyok[:, None, :])[None, None, :, None]
    m = jnp.max(jnp.where(valid, sc, NEG), axis=-1)
    e = jnp.where(valid, jnp.exp(sc - m[..., None]), 0.0)
    l = jnp.sum(e, axis=-1)
    o = jnp.einsum('brnhqk,brnkhc->brnqhc', (e / l[..., None]).astype(v.dtype), vw)
    o = o.reshape(B, dil, Lp, H, Dh)[:, :, :L].transpose(0, 2, 1, 3, 4).reshape(B, S, H, Dh)

    def back(s):
        s = s.transpose(0, 1, 2, 4, 3).reshape(B, dil, Lp, H)[:, :, :L]
        return s.transpose(0, 2, 1, 3).reshape(B, S, H)

    return o, back(m), back(l)


def setup_inputs(seed: int = 0) -> dict:
    key = jax.random.key(seed)
    ks = jax.random.split(key, 32)
    f32 = jnp.float32

    def nrm(k, shape, fan):
        return jax.random.normal(k, shape, f32) * fan ** -0.5

    def gain(k, shape):
        return 1.0 + 0.1 * jax.random.normal(k, shape, f32)

    Dp = DEPTH
    return {
        "x": jax.random.normal(ks[0], (BATCH, SEQ, D_MODEL), f32),
        "p": jax.random.normal(ks[1], (DEPTH, BATCH, SEQ, PLE_DIM), f32),
        "positions": jnp.arange(SEQ, dtype=jnp.int32)[None, :]
        + jax.random.randint(ks[2], (BATCH, 1), 0, 4096, dtype=jnp.int32),
        "g_ffn1": gain(ks[3], (Dp, D_MODEL)),
        "w1_gate": nrm(ks[4], (Dp, D_MODEL, D_FF), D_MODEL),
        "w1_up": nrm(ks[5], (Dp, D_MODEL, D_FF), D_MODEL),
        "w1_down": nrm(ks[6], (Dp, D_FF, D_MODEL), D_FF),
        "g_mix": gain(ks[7], (Dp, D_MODEL)),
        "w_in": nrm(ks[8], (Dp, D_MODEL, D_IN), D_MODEL),
        "g_cq": gain(ks[9], (Dp, Q_LORA)),
        "w_uq": nrm(ks[10], (Dp, Q_LORA, N_HEADS_MLA * MLA_QK), Q_LORA),
        "g_ckv": gain(ks[11], (Dp, KV_LORA)),
        "w_ukv": nrm(ks[12], (Dp, KV_LORA, N_HEADS_MLA * (MLA_NOPE + MLA_V)), KV_LORA),
        "g_q_mla": gain(ks[13], (Dp, MLA_QK)),
        "g_k_mla": gain(ks[14], (Dp, MLA_QK)),
        "g_q_dil": gain(ks[15], (Dp, N_DIL_GROUPS, DIL_HEAD)),
        "g_k_dil": gain(ks[16], (Dp, N_DIL_GROUPS, DIL_HEAD)),
        "w_br_mla": nrm(ks[17], (Dp, N_HEADS_MLA * MLA_V, D_MODEL), N_HEADS_MLA * MLA_V),
        "w_br_dil": nrm(ks[18], (Dp, N_HEADS_DIL * DIL_HEAD, D_MODEL), N_HEADS_DIL * DIL_HEAD),
        "w_o": nrm(ks[19], (Dp, D_MODEL, D_MODEL), D_MODEL),
        "g_ffn2": gain(ks[20], (Dp, D_MODEL)),
        "w2_gate": nrm(ks[21], (Dp, D_MODEL, D_FF), D_MODEL),
        "w2_up": nrm(ks[22], (Dp, D_MODEL, D_FF), D_MODEL),
        "w2_down": nrm(ks[23], (Dp, D_FF, D_MODEL), D_FF),
        "g_ple": gain(ks[24], (Dp, D_MODEL)),
        "w_ple_gate": nrm(ks[25], (Dp, D_MODEL, D_MODEL), D_MODEL),
        "w_ple_proj": nrm(ks[26], (Dp, PLE_DIM, D_MODEL), PLE_DIM),
    }


def reference(x, p, positions, g_ffn1, w1_gate, w1_up, w1_down, g_mix, w_in, g_cq, w_uq,
              g_ckv, w_ukv, g_q_mla, g_k_mla, g_q_dil, g_k_dil, w_br_mla, w_br_dil, w_o,
              g_ffn2, w2_gate, w2_up, w2_down, g_ple, w_ple_gate, w_ple_proj):
    B, S, _ = x.shape
    scale_mla = MLA_QK ** -0.5
    scale_dil = DIL_HEAD ** -0.5
    for i in range(DEPTH):
        x = x + 0.5 * swiglu(rmsnorm(x, g_ffn1[i]), w1_gate[i], w1_up[i], w1_down[i])

        h = rmsnorm(x, g_mix[i])
        proj = h @ w_in[i]

        cq = rmsnorm(proj[..., OFF_CQ:OFF_CKV], g_cq[i])
        q = (cq @ w_uq[i]).reshape(B, S, N_HEADS_MLA, MLA_QK)
        ckv = rmsnorm(proj[..., OFF_CKV:OFF_KR], g_ckv[i])
        kv = (ckv @ w_ukv[i]).reshape(B, S, N_HEADS_MLA, MLA_NOPE + MLA_V)
        k_nope, v = kv[..., :MLA_NOPE], kv[..., MLA_NOPE:]
        k_rope = jnp.broadcast_to(proj[:, :, None, OFF_KR:OFF_DIL], (B, S, N_HEADS_MLA, MLA_ROPE))
        k = jnp.concatenate([k_nope, k_rope], axis=-1)
        q = rmsnorm(q, g_q_mla[i])
        k = rmsnorm(k, g_k_mla[i])
        q = jnp.concatenate([q[..., :MLA_NOPE], rope(q[..., MLA_NOPE:], positions)], axis=-1) * scale_mla
        k = jnp.concatenate([k[..., :MLA_NOPE], rope(k[..., MLA_NOPE:], positions)], axis=-1)
        o_mla = causal_block_attention(q, k, v).reshape(B, S, N_HEADS_MLA * MLA_V)

        dqkv = proj[..., OFF_DIL:OFF_GATE].reshape(B, S, N_DIL_GROUPS, 3, N_HEADS_DIL, DIL_HEAD)
        outs, ms, ls = [], [], []
        for g, (win, dil) in enumerate(DIL_GROUPS):
            qg = rmsnorm(dqkv[:, :, g, 0], g_q_dil[i, g])
            kg = rmsnorm(dqkv[:, :, g, 1], g_k_dil[i, g])
            vg = dqkv[:, :, g, 2]
            qg = jnp.concatenate([rope(qg[..., :DIL_ROT], positions), qg[..., DIL_ROT:]], axis=-1) * scale_dil
            kg = jnp.concatenate([rope(kg[..., :DIL_ROT], positions), kg[..., DIL_ROT:]], axis=-1)
            o, m, l = dilated_window_attention(qg, kg, vg, dil, win // dil)
            outs.append(o)
            ms.append(m)
            ls.append(l)
        m_all = jnp.stack(ms, axis=0)
        l_all = jnp.stack(ls, axis=0)
        wgt = l_all * jnp.exp(m_all - jnp.max(m_all, axis=0, keepdims=True))
        wgt = wgt / jnp.sum(wgt, axis=0, keepdims=True)
        o_dil = jnp.einsum('gbsh,gbshc->bshc', wgt.astype(x.dtype), jnp.stack(outs, axis=0))
        o_dil = o_dil.reshape(B, S, N_HEADS_DIL * DIL_HEAD)

        gates = jax.nn.sigmoid(proj[..., OFF_GATE:].reshape(B, S, N_BRANCH, D_MODEL))
        merged = gates[:, :, 0] * (o_mla @ w_br_mla[i]) + gates[:, :, 1] * (o_dil @ w_br_dil[i])
        x = x + merged @ w_o[i]

        x = x + 0.5 * swiglu(rmsnorm(x, g_ffn2[i]), w2_gate[i], w2_up[i], w2_down[i])

        ple_gate = jax.nn.sigmoid(rmsnorm(x, g_ple[i]) @ w_ple_gate[i])
        x = x + ple_gate * (p[i] @ w_ple_proj[i])
    return x
```

```cpp
#include <hip/hip_runtime.h>
#include <hip/hip_cooperative_groups.h>
#include <cstdio>
#include <cstdint>
namespace cg = cooperative_groups;

#ifndef MK_PER_PHASE
#define MK_PER_PHASE 0
#endif

namespace pg8 {
#define PG8_LAS __attribute__((address_space(3)))
typedef unsigned short bf16_t;
typedef short bf16x8 __attribute__((ext_vector_type(8)));
typedef float f32x4 __attribute__((ext_vector_type(4)));
typedef unsigned u32x4 __attribute__((ext_vector_type(4)));
constexpr int BM = 256, BK = 64, HALF = 128, HTB = HALF * BK * 2  , STAGE_BYTES = 8 * HTB, NXCD = 8, WGM = 8;

__host__ __device__ __forceinline__ int lds_byte(int r, int c) { const int st = (r >> 4) * 2 + (c >> 5), rr = r & 15, cc = c & 31, ob = rr * 64 + cc * 2; return st * 1024 + (ob ^ (((ob >> 9) & 1) << 5)); }
__host__ __device__ __forceinline__ void stage_rc(int b, int& R, int& C) { const int st = b / 1024, sb = b % 1024, swz = sb ^ (((sb >> 9) & 1) << 5); R = (st >> 1) * 16 + swz / 64; C = (st & 1) * 32 + (swz % 64) / 2; }
__host__ __device__ __forceinline__ int perm32(int rho) { const int n = rho >> 4, i = rho & 15; return 8 * (i >> 2) + 4 * n + (i & 3); }

struct Unit { int pm, pn; };
struct Gemm { const bf16_t* A; const bf16_t* Bt; int M, N, K, lda, ldb; };

struct StaticOrder {
    int nM, nN, nwg, G, c;
    __host__ __device__ void init(int M, int N, int G_, int c_) { nM = M / BM; nN = N / BM; nwg = nM * nN; G = G_; c = c_; }
    __host__ __device__ bool next(int i, Unit& u) const {
        const long L = (long)i * G + c; if (L >= nwg) return false;
        int wgid = (int)L; { const int q = nwg / NXCD, r = nwg % NXCD, xcd = wgid % NXCD, off = wgid / NXCD; wgid = (xcd < r ? xcd * (q + 1) : r * (q + 1) + (xcd - r) * q) + off; }
        const int nig = WGM * nN, gid = wgid / nig, fm = gid * WGM, gsz = (nM - fm) < WGM ? (nM - fm) : WGM;
        u.pm = fm + ((wgid % nig) % gsz); u.pn = (wgid % nig) / gsz; return true;
    }
    __device__ __forceinline__ void a_ready(const Unit&) const {}
    __device__ __forceinline__ void done(const Unit&) const {}
};

__device__ __forceinline__ unsigned cvt_pk_bf16(float lo, float hi) { unsigned r; asm volatile("v_cvt_pk_bf16_f32 %0, %1, %2" : "=v"(r) : "v"(lo), "v"(hi)); return r; }
__device__ __forceinline__ float bf_lo(unsigned w) { return __uint_as_float(w << 16); }
__device__ __forceinline__ float bf_hi(unsigned w) { return __uint_as_float(w & 0xffff0000u); }
__device__ __forceinline__ float sigm(float v) { return __builtin_amdgcn_rcpf(1.f + __builtin_amdgcn_exp2f(-1.4426950408889634f * v)); }
__device__ __forceinline__ u32x4 pack8(f32x4 a, f32x4 b) { u32x4 w; w.x = cvt_pk_bf16(a[0], a[1]); w.y = cvt_pk_bf16(a[2], a[3]); w.z = cvt_pk_bf16(b[0], b[1]); w.w = cvt_pk_bf16(b[2], b[3]); return w; }
__device__ __forceinline__ void unpack8(u32x4 w, f32x4& a, f32x4& b) { a = (f32x4){bf_lo(w.x), bf_hi(w.x), bf_lo(w.y), bf_hi(w.y)}; b = (f32x4){bf_lo(w.z), bf_hi(w.z), bf_lo(w.w), bf_hi(w.w)}; }
constexpr float EPSN = 1e-6f;
struct EpiSwiGLU { static constexpr bool PERM = true, AFTER_DRAIN = false;
    bf16_t* O; int ldo; const float* ss; float inv_dim;
    __device__ __forceinline__ void operator()(const f32x4 (&acc)[2][2][4][2], const Unit& u, int wr, int wc, int fr, int fq) const {
        const int col0 = u.pn * 128 + wc * 32 + 8 * fq;
#pragma unroll
        for (int ai = 0; ai < 2; ++ai)
#pragma unroll
            for (int m = 0; m < 4; ++m) { const int row = u.pm * BM + ai * HALF + wr * 64 + m * 16 + fr; const float rs = rsqrtf(ss[row] * inv_dim + EPSN);
                f32x4 o[2];
#pragma unroll
                for (int n = 0; n < 2; ++n) { const f32x4 g = acc[ai][0][m][n] * rs, up = acc[ai][1][m][n] * rs;
#pragma unroll
                    for (int e = 0; e < 4; ++e) o[n][e] = g[e] * sigm(g[e]) * up[e]; }
                *(u32x4*)(O + (size_t)row * ldo + col0) = pack8(o[0], o[1]); }
    }
};
struct EpiResid { static constexpr bool PERM = true, AFTER_DRAIN = false;
    const float* base; float* out; bf16_t* xb; float* ssn; float alpha;
    __device__ __forceinline__ void operator()(const f32x4 (&acc)[2][2][4][2], const Unit& u, int wr, int wc, int fr, int fq) const {
#pragma unroll
        for (int ai = 0; ai < 2; ++ai)
#pragma unroll
            for (int m = 0; m < 4; ++m) { const int row = u.pm * BM + ai * HALF + wr * 64 + m * 16 + fr; float s = 0.f;
#pragma unroll
                for (int bj = 0; bj < 2; ++bj) { const size_t off = (size_t)row * 2048 + u.pn * BM + bj * HALF + wc * 32 + 8 * fq;
                    const f32x4 v0 = *(const f32x4*)(base + off) + acc[ai][bj][m][0] * alpha, v1 = *(const f32x4*)(base + off + 4) + acc[ai][bj][m][1] * alpha;
                    *(f32x4*)(out + off) = v0; *(f32x4*)(out + off + 4) = v1; *(u32x4*)(xb + off) = pack8(v0, v1);
                    s += (v0[0] * v0[0] + v0[1] * v0[1]) + (v0[2] * v0[2] + v0[3] * v0[3]) + (v1[0] * v1[0] + v1[1] * v1[1]) + (v1[2] * v1[2] + v1[3] * v1[3]); }
                s += __shfl_xor(s, 16); s += __shfl_xor(s, 32);
                if (fq == 0) atomicAdd(ssn + row, s);
                asm volatile("" ::: "memory"); }
    }
};
template <int ACT> struct EpiScale { static constexpr bool PERM = true, AFTER_DRAIN = false;
    bf16_t* O; int ldc; const float* ss; float inv_dim;
    __device__ __forceinline__ void operator()(const f32x4 (&acc)[2][2][4][2], const Unit& u, int wr, int wc, int fr, int fq) const {
#pragma unroll
        for (int ai = 0; ai < 2; ++ai)
#pragma unroll
            for (int m = 0; m < 4; ++m) { const int row = u.pm * BM + ai * HALF + wr * 64 + m * 16 + fr; const float rs = ss ? rsqrtf(ss[row] * inv_dim + EPSN) : 1.f;
#pragma unroll
                for (int bj = 0; bj < 2; ++bj) { f32x4 v0 = acc[ai][bj][m][0] * rs, v1 = acc[ai][bj][m][1] * rs;
                    if (ACT == 1) {
#pragma unroll
                        for (int e = 0; e < 4; ++e) { v0[e] = sigm(v0[e]); v1[e] = sigm(v1[e]); } }
                    *(u32x4*)(O + (size_t)row * ldc + u.pn * BM + bj * HALF + wc * 32 + 8 * fq) = pack8(v0, v1); } }
    }
};
struct EpiP3b { static constexpr bool PERM = true, AFTER_DRAIN = false;
    bf16_t* small; bf16_t* gates; const float* ss; float* ss_cq; float* ss_ckv;
    __device__ __forceinline__ void operator()(const f32x4 (&acc)[2][2][4][2], const Unit& u, int wr, int wc, int fr, int fq) const {
        const bool sm = u.pn < 4; bf16_t* O = sm ? small : gates; const int ldc = sm ? 1024 : 4096, colt = sm ? u.pn * BM : (u.pn - 4) * BM;
        float* ssq = (u.pn < 2) ? ss_cq : (u.pn == 2 ? ss_ckv : nullptr);
#pragma unroll
        for (int ai = 0; ai < 2; ++ai)
#pragma unroll
            for (int m = 0; m < 4; ++m) { const int row = u.pm * BM + ai * HALF + wr * 64 + m * 16 + fr; const float rs = rsqrtf(ss[row] * (1.f / 2048.f) + EPSN); float s = 0.f;
#pragma unroll
                for (int bj = 0; bj < 2; ++bj) { f32x4 v0 = acc[ai][bj][m][0] * rs, v1 = acc[ai][bj][m][1] * rs;
                    if (!sm) {
#pragma unroll
                        for (int e = 0; e < 4; ++e) { v0[e] = sigm(v0[e]); v1[e] = sigm(v1[e]); } }
                    s += (v0[0] * v0[0] + v0[1] * v0[1]) + (v0[2] * v0[2] + v0[3] * v0[3]) + (v1[0] * v1[0] + v1[1] * v1[1]) + (v1[2] * v1[2] + v1[3] * v1[3]);
                    *(u32x4*)(O + (size_t)row * ldc + colt + bj * HALF + wc * 32 + 8 * fq) = pack8(v0, v1); }
                if (ssq) { s += __shfl_xor(s, 16); s += __shfl_xor(s, 32); if (fq == 0) atomicAdd(ssq + row, s); } }
    }
};
template <bool FIRST> struct EpiBr { static constexpr bool PERM = true, AFTER_DRAIN = false;
    bf16_t* T; const bf16_t* gates;
    __device__ __forceinline__ void operator()(const f32x4 (&acc)[2][2][4][2], const Unit& u, int wr, int wc, int fr, int fq) const {
#pragma unroll
        for (int ai = 0; ai < 2; ++ai)
#pragma unroll
            for (int m = 0; m < 4; ++m) { const int row = u.pm * BM + ai * HALF + wr * 64 + m * 16 + fr;
#pragma unroll
                for (int bj = 0; bj < 2; ++bj) { const int c = u.pn * BM + bj * HALF + wc * 32 + 8 * fq;
                    f32x4 g0, g1; unpack8(*(const u32x4*)(gates + (size_t)row * 4096 + (FIRST ? 0 : 2048) + c), g0, g1);
                    f32x4 v0 = acc[ai][bj][m][0] * g0, v1 = acc[ai][bj][m][1] * g1;
                    bf16_t* tp = T + (size_t)row * 2048 + c;
                    if (!FIRST) { f32x4 t0, t1; unpack8(*(const u32x4*)tp, t0, t1); v0 += t0; v1 += t1; }
                    *(u32x4*)tp = pack8(v0, v1); }
                asm volatile("" ::: "memory"); }
    }
};
struct EpiPle { static constexpr bool PERM = true, AFTER_DRAIN = false;
    float* out; const bf16_t* T; const float* ss;
    __device__ __forceinline__ void operator()(const f32x4 (&acc)[2][2][4][2], const Unit& u, int wr, int wc, int fr, int fq) const {
        int row = u.pm * BM + wr * 64 + fr; const int col = u.pn * BM + wc * 32 + 8 * fq;
#pragma unroll
        for (int ai = 0; ai < 2; ++ai) {
#pragma unroll
            for (int m = 0; m < 4; ++m) { asm volatile("" : "+v"(row)); const float rs = rsqrtf(ss[row] * (1.f / 2048.f) + EPSN);
                unsigned off = (unsigned)row * 2048u + (unsigned)col;
#pragma unroll
                for (int bj = 0; bj < 2; ++bj) { asm volatile("" : "+v"(off));
                    f32x4 g0, g1;
#pragma unroll
                    for (int e = 0; e < 4; ++e) { g0[e] = sigm(acc[ai][bj][m][0][e] * rs); g1[e] = sigm(acc[ai][bj][m][1][e] * rs); }
                    f32x4 t0, t1; unpack8(*(const u32x4*)(T + off), t0, t1);
                    f32x4 v0 = *(const f32x4*)(out + off) + g0 * t0; *(f32x4*)(out + off) = v0;
                    f32x4 v1 = *(const f32x4*)(out + off + 4) + g1 * t1; *(f32x4*)(out + off + 4) = v1;
                    asm volatile("" ::: "memory"); off += HALF; }
                row += 16; }
            row += 64; }
    }
};
template <class Epi, class Sched, bool ALIGN_EPI = false, bool SP2 = false>
__device__ __forceinline__ void gemm_phase(PG8_LAS unsigned char* lds, const Gemm g, const Sched& S, const Epi& E) {
    const int tid = threadIdx.x, wid = __builtin_amdgcn_readfirstlane(tid >> 6), lane = tid & 63, wr = wid >> 2, wc = wid & 3, fr = lane & 15, fq = lane >> 4;
    int K = g.K; asm volatile("" : "+s"(K)); const int nt = K / BK;
    unsigned voffA[2], voffB[2];
#pragma unroll
    for (int i = 0; i < 2; ++i) { int R, C; stage_rc(tid * 16 + i * 8192, R, C); const int Rb = Epi::PERM ? ((R & ~31) + perm32(R & 31)) : R;
        voffA[i] = (unsigned)(R * g.lda + C) * 2u; voffB[i] = (unsigned)(Rb * g.ldb + C) * 2u; }
    const size_t kstep = (size_t)(BK * 2);
    const size_t hstepA = (size_t)HALF * g.lda * 2, hstepB = (size_t)HALF * g.ldb * 2;
    const size_t tstepA = 2 * hstepA, tstepB = 2 * hstepB;
    const unsigned ldsw = (unsigned)wid * 1024u;
    const int aoff = lds_byte(wr * 64 + fr, fq * 8), boff = lds_byte(wc * 32 + fr, fq * 8);
#define PG8_SA(b, h) (((b) * 2 + (h)) * HTB)
#define PG8_SB(b, h) ((4 + (b) * 2 + (h)) * HTB)
#define PG8_STAGE(bufoff, gbase, voff) do { _Pragma("unroll") for (int _i = 0; _i < 2; ++_i) \
        __builtin_amdgcn_global_load_lds((const unsigned*)((const char*)(gbase) + (voff)[_i]), (PG8_LAS unsigned*)(lds + (bufoff) + ldsw + _i * 8192), 16, 0, 0); } while (0)
#define PG8_LDA(dst, b, h) do { _Pragma("unroll") for (int m = 0; m < 4; ++m) _Pragma("unroll") for (int k = 0; k < 2; ++k) dst[m][k] = *(const PG8_LAS bf16x8*)(lds + PG8_SA(b, h) + aoff + m * 2048 + k * 1024); } while (0)
#define PG8_LDB(dst, b, h) do { _Pragma("unroll") for (int n = 0; n < 2; ++n) _Pragma("unroll") for (int k = 0; k < 2; ++k) dst[n][k] = *(const PG8_LAS bf16x8*)(lds + PG8_SB(b, h) + boff + n * 2048 + k * 1024); } while (0)
#define PG8_MMA(ai, bj, At, Bt) do { __builtin_amdgcn_s_setprio(1); _Pragma("unroll") for (int m = 0; m < 4; ++m) _Pragma("unroll") for (int n = 0; n < 2; ++n) _Pragma("unroll") for (int k = 0; k < 2; ++k) \
        acc[ai][bj][m][n] = __builtin_amdgcn_mfma_f32_16x16x32_bf16(Bt[n][k], At[m][k], acc[ai][bj][m][n], 0, 0, 0); __builtin_amdgcn_s_setprio(0); } while (0)
#define PG8_WAIT_V(n) asm volatile("s_waitcnt vmcnt(" #n ")" ::: "memory")
#define PG8_WAIT_L(n) asm volatile("s_waitcnt lgkmcnt(" #n ")" ::: "memory")
#define PG8_BAR __builtin_amdgcn_s_barrier()
#define PG8_SCHED __builtin_amdgcn_sched_barrier(0)
    Unit cur, nxt; int ui = 0;
    if (!S.next(0, cur)) return;
    f32x4 acc[2][2][4][2];
#pragma unroll
    for (int a = 0; a < 2; ++a)
#pragma unroll
        for (int b = 0; b < 2; ++b)
#pragma unroll
            for (int m = 0; m < 4; ++m)
#pragma unroll
                for (int n = 0; n < 2; ++n) acc[a][b][m][n] = (f32x4){0.f, 0.f, 0.f, 0.f};
    bf16x8 At[4][2], B0[2][2], B1[2][2];
    const char* cA = (const char*)g.A + (size_t)cur.pm * tstepA; const char* cB = (const char*)g.Bt + (size_t)cur.pn * tstepB;
    S.a_ready(cur);
    if constexpr (SP2) {
        PG8_STAGE(PG8_SB(0, 0), cB, voffB); PG8_STAGE(PG8_SB(0, 1), cB + hstepB, voffB); PG8_STAGE(PG8_SA(0, 0), cA, voffA); PG8_STAGE(PG8_SA(0, 1), cA + hstepA, voffA);
        if (wr == 1) PG8_BAR;
        PG8_WAIT_V(2); PG8_BAR;
        PG8_STAGE(PG8_SB(1, 0), cB + kstep, voffB); PG8_STAGE(PG8_SA(1, 0), cA + kstep, voffA); PG8_STAGE(PG8_SB(1, 1), cB + hstepB + kstep, voffB);
        PG8_WAIT_V(6); PG8_BAR;
    } else {
        PG8_STAGE(PG8_SB(0, 0), cB, voffB); PG8_STAGE(PG8_SA(0, 0), cA, voffA); PG8_STAGE(PG8_SB(0, 1), cB + hstepB, voffB); PG8_STAGE(PG8_SA(0, 1), cA + hstepA, voffA);
        if (wr == 1) PG8_BAR;
        PG8_WAIT_V(4); PG8_BAR;
        PG8_STAGE(PG8_SB(1, 0), cB + kstep, voffB); PG8_STAGE(PG8_SA(1, 0), cA + kstep, voffA); PG8_STAGE(PG8_SB(1, 1), cB + hstepB + kstep, voffB);
        PG8_WAIT_V(6); PG8_BAR;
    }
    for (;;) {
        const bool has_next = S.next(ui + 1, nxt);
        const char* nA = has_next ? (const char*)g.A + (size_t)nxt.pm * tstepA : cA; const char* nB = has_next ? (const char*)g.Bt + (size_t)nxt.pn * tstepB : cB;
        for (int t = 0; t < nt; t += 2) {
            const bool last = (t == nt - 2);
            const char* a1 = cA + (size_t)(t + 1) * kstep;
            const char* a2 = last ? nA : cA + (size_t)(t + 2) * kstep; const char* b2 = last ? nB : cB + (size_t)(t + 2) * kstep;
            const char* a3 = a2 + kstep; const char* b3 = b2 + kstep;
            if (last && has_next) S.a_ready(nxt);
            if constexpr (SP2) {
            PG8_LDB(B0, 0, 0); PG8_LDB(B1, 0, 1); PG8_SCHED; PG8_LDA(At, 0, 0); PG8_STAGE(PG8_SA(1, 1), a1 + hstepA, voffA);
            PG8_WAIT_V(8); PG8_WAIT_L(0); PG8_BAR; PG8_MMA(0, 0, At, B0); PG8_MMA(0, 1, At, B1); PG8_BAR; PG8_SCHED;
            PG8_LDA(At, 0, 1); PG8_STAGE(PG8_SB(0, 0), b2, voffB); PG8_STAGE(PG8_SB(0, 1), b2 + hstepB, voffB); PG8_STAGE(PG8_SA(0, 0), a2, voffA);
            PG8_WAIT_V(8); PG8_WAIT_L(0); PG8_BAR; PG8_MMA(1, 0, At, B0); PG8_MMA(1, 1, At, B1); PG8_BAR; PG8_SCHED;
            PG8_LDB(B0, 1, 0); PG8_LDB(B1, 1, 1); PG8_SCHED; PG8_LDA(At, 1, 0); PG8_STAGE(PG8_SA(0, 1), a2 + hstepA, voffA);
            PG8_WAIT_V(8); PG8_WAIT_L(0); PG8_BAR; PG8_MMA(0, 0, At, B0); PG8_MMA(0, 1, At, B1); PG8_BAR; PG8_SCHED;
            PG8_LDA(At, 1, 1); PG8_STAGE(PG8_SB(1, 0), b3, voffB); PG8_STAGE(PG8_SB(1, 1), b3 + hstepB, voffB); PG8_STAGE(PG8_SA(1, 0), a3, voffA);
            PG8_WAIT_V(8); PG8_WAIT_L(0); PG8_BAR; PG8_MMA(1, 0, At, B0); PG8_MMA(1, 1, At, B1); PG8_BAR; PG8_SCHED;
            } else {
            PG8_LDB(B0, 0, 0); PG8_SCHED; PG8_LDA(At, 0, 0); PG8_STAGE(PG8_SA(1, 1), a1 + hstepA, voffA);
            PG8_WAIT_L(8); PG8_BAR; PG8_WAIT_L(0); PG8_MMA(0, 0, At, B0); PG8_BAR; PG8_SCHED;
            PG8_LDB(B1, 0, 1); PG8_STAGE(PG8_SB(0, 0), b2, voffB);
            PG8_BAR; PG8_WAIT_L(0); PG8_MMA(0, 1, At, B1); PG8_BAR;
            PG8_LDA(At, 0, 1); PG8_STAGE(PG8_SA(0, 0), a2, voffA);
            PG8_BAR; PG8_WAIT_L(0); PG8_MMA(1, 0, At, B0); PG8_BAR; PG8_SCHED;
            PG8_STAGE(PG8_SB(0, 1), b2 + hstepB, voffB);
            PG8_WAIT_V(6); PG8_BAR; PG8_MMA(1, 1, At, B1); PG8_BAR;
            PG8_LDB(B0, 1, 0); PG8_SCHED; PG8_LDA(At, 1, 0); PG8_STAGE(PG8_SA(0, 1), a2 + hstepA, voffA);
            PG8_WAIT_L(8); PG8_BAR; PG8_WAIT_L(0); PG8_MMA(0, 0, At, B0); PG8_BAR; PG8_SCHED;
            PG8_LDB(B1, 1, 1); PG8_STAGE(PG8_SB(1, 0), b3, voffB);
            PG8_BAR; PG8_WAIT_L(0); PG8_MMA(0, 1, At, B1); PG8_BAR;
            PG8_LDA(At, 1, 1); PG8_STAGE(PG8_SA(1, 0), a3, voffA);
            PG8_BAR; PG8_WAIT_L(0); PG8_MMA(1, 0, At, B0); PG8_BAR; PG8_SCHED;
            PG8_STAGE(PG8_SB(1, 1), b3 + hstepB, voffB);
            PG8_WAIT_V(6); PG8_BAR; PG8_MMA(1, 1, At, B1); PG8_BAR;
            }
        }
        if constexpr (ALIGN_EPI) { if (wr == 0) PG8_BAR; }
        if constexpr (!Epi::AFTER_DRAIN) { E(acc, cur, wr, wc, fr, fq); S.done(cur); }
        if (!has_next) break;
#pragma unroll
        for (int a = 0; a < 2; ++a)
#pragma unroll
            for (int b = 0; b < 2; ++b)
#pragma unroll
                for (int m = 0; m < 4; ++m)
#pragma unroll
                    for (int n = 0; n < 2; ++n) acc[a][b][m][n] = (f32x4){0.f, 0.f, 0.f, 0.f};
        cur = nxt; cA = nA; cB = nB; ++ui;
        if constexpr (ALIGN_EPI) { if (wr == 1) PG8_BAR; }
    }
    PG8_WAIT_V(0);
    if constexpr (!ALIGN_EPI) { if (wr == 0) PG8_BAR; }
    PG8_BAR;
    if constexpr (Epi::AFTER_DRAIN) { E.fused(acc, cur, wr, wc, fr, fq, lds, wid, lane); S.done(cur); }
#undef PG8_SA
#undef PG8_SB
#undef PG8_STAGE
#undef PG8_LDA
#undef PG8_LDB
#undef PG8_MMA
#undef PG8_WAIT_V
#undef PG8_WAIT_L
#undef PG8_BAR
#undef PG8_SCHED
}
}

namespace att {
typedef unsigned short bf16_t;
typedef short bf16x8 __attribute__((ext_vector_type(8)));
typedef short s16x4 __attribute__((ext_vector_type(4)));
typedef float f32x16 __attribute__((ext_vector_type(16)));
typedef unsigned u32x4 __attribute__((ext_vector_type(4)));
constexpr int NW = 8, QBLK = 32, KVBLK = 64, QB = 256, SHM_V = 16384;
constexpr float THR = 8.f;
#define ALAS __attribute__((address_space(3)))
#define SBAR() __builtin_amdgcn_sched_barrier(0)
__device__ __forceinline__ int v_st(int k, int c) { const int kk = (k & ~0xC) | ((k & 4) << 1) | ((k & 8) >> 1); return ((kk >> 3) * 4 + (c >> 5)) * 512 + ((kk & 7) * 32 + (c & 31)) * 2; }
__device__ __forceinline__ int v_rd_base(int lane) { return ((lane & 3) << 3) | (((lane >> 2) & 3) << 6) | (((lane >> 4) & 1) << 5) | (((lane >> 5) & 1) << 8); }
constexpr int v_rd_off(int d0, int ks, int half) { return d0 * 512 + ks * 4096 + half * 2048; }
__device__ __forceinline__ int crow(int r, int hi) { return (r & 3) + 8 * (r >> 2) + 4 * hi; }
__device__ __forceinline__ unsigned cvtpk(float lo, float hi) { unsigned r; asm volatile("v_cvt_pk_bf16_f32 %0, %1, %2" : "=v"(r) : "v"(lo), "v"(hi)); return r; }
__device__ __forceinline__ void mask_tile(f32x16& p0, f32x16& p1, int dq, unsigned W) {
    const float NEG = -__builtin_inff();
#pragma unroll
    for (int r = 0; r < 16; ++r) { const int c = (r & 3) + 8 * (r >> 2);
        if ((unsigned)(dq - c) >= W) p0[r] = NEG;
        if ((unsigned)(dq - c - 32) >= W) p1[r] = NEG; }
}
__device__ __forceinline__ void softmax_tile(f32x16& p0, f32x16& p1, float& m_reg, float& l_reg, float& alpha, bf16x8& pa0, bf16x8& pa1, bf16x8& pa2, bf16x8& pa3) {
    float pmax = p0[0];
#pragma unroll
    for (int r = 1; r < 16; ++r) pmax = fmaxf(pmax, p0[r]);
#pragma unroll
    for (int r = 0; r < 16; ++r) pmax = fmaxf(pmax, p1[r]);
    { auto rr = __builtin_amdgcn_permlane32_swap(__float_as_uint(pmax), __float_as_uint(pmax), false, false); pmax = fmaxf(__uint_as_float(rr[0]), __uint_as_float(rr[1])); }
    float mn;
    if (__builtin_expect(__all((pmax - m_reg) <= THR), 1)) { mn = m_reg; alpha = 1.f; }
    else { mn = fmaxf(m_reg, pmax); alpha = __builtin_amdgcn_exp2f(m_reg - mn); m_reg = mn; }
#pragma unroll
    for (int r = 0; r < 16; ++r) { p0[r] = __builtin_amdgcn_exp2f(p0[r] - mn); p1[r] = __builtin_amdgcn_exp2f(p1[r] - mn); }
    float ps = 0.f;
#pragma unroll
    for (int r = 0; r < 16; ++r) ps += p0[r];
#pragma unroll
    for (int r = 0; r < 16; ++r) ps += p1[r];
    { auto rr = __builtin_amdgcn_permlane32_swap(__float_as_uint(ps), __float_as_uint(ps), false, false); ps = __uint_as_float(rr[0]) + __uint_as_float(rr[1]); }
    l_reg = l_reg * alpha + ps;
#define PK4(P, B_, OUT) do { unsigned a0 = cvtpk(P[B_+0], P[B_+1]), a1 = cvtpk(P[B_+2], P[B_+3]); unsigned b0 = cvtpk(P[B_+4], P[B_+5]), b1 = cvtpk(P[B_+6], P[B_+7]); \
        auto r0 = __builtin_amdgcn_permlane32_swap(a0, b0, false, false); auto r1 = __builtin_amdgcn_permlane32_swap(a1, b1, false, false); \
        u32x4 w = {r0[0], r1[0], r0[1], r1[1]}; OUT = *reinterpret_cast<bf16x8*>(&w); } while (0)
    PK4(p0, 0, pa0); PK4(p0, 8, pa1); PK4(p1, 0, pa2); PK4(p1, 8, pa3);
#undef PK4
}
template <bool PF> __device__ __forceinline__ void pv_tile(f32x16* o, int vb0, bf16x8 pa0, bf16x8 pa1, bf16x8 pa2, bf16x8 pa3) {
#define TRRD(dst, off) asm volatile("ds_read_b64_tr_b16 %0, %1 offset:%2" : "=&v"(dst) : "v"(vb0), "i"(off) : "memory")
#define RD8(L, d0) do { constexpr int b_ = v_rd_off(d0, 0, 0); TRRD(L[0], b_); TRRD(L[1], b_ + 2048); TRRD(L[2], b_ + 4096); TRRD(L[3], b_ + 6144); TRRD(L[4], b_ + 8192); TRRD(L[5], b_ + 10240); TRRD(L[6], b_ + 12288); TRRD(L[7], b_ + 14336); } while (0)
#define MM4(L, d0) do { \
        o[d0] = __builtin_amdgcn_mfma_f32_32x32x16_bf16(pa0, (bf16x8){L[0][0], L[0][1], L[0][2], L[0][3], L[1][0], L[1][1], L[1][2], L[1][3]}, o[d0], 0, 0, 0); \
        o[d0] = __builtin_amdgcn_mfma_f32_32x32x16_bf16(pa1, (bf16x8){L[2][0], L[2][1], L[2][2], L[2][3], L[3][0], L[3][1], L[3][2], L[3][3]}, o[d0], 0, 0, 0); \
        o[d0] = __builtin_amdgcn_mfma_f32_32x32x16_bf16(pa2, (bf16x8){L[4][0], L[4][1], L[4][2], L[4][3], L[5][0], L[5][1], L[5][2], L[5][3]}, o[d0], 0, 0, 0); \
        o[d0] = __builtin_amdgcn_mfma_f32_32x32x16_bf16(pa3, (bf16x8){L[6][0], L[6][1], L[6][2], L[6][3], L[7][0], L[7][1], L[7][2], L[7][3]}, o[d0], 0, 0, 0); } while (0)
    if constexpr (PF) {
    s16x4 A[8], B[8];
    RD8(A, 0); RD8(B, 1);
    asm volatile("s_waitcnt lgkmcnt(8)" ::: "memory"); SBAR(); MM4(A, 0); SBAR();
    RD8(A, 2);
    asm volatile("s_waitcnt lgkmcnt(8)" ::: "memory"); SBAR(); MM4(B, 1); SBAR();
    RD8(B, 3);
    asm volatile("s_waitcnt lgkmcnt(8)" ::: "memory"); SBAR(); MM4(A, 2); SBAR();
    asm volatile("s_waitcnt lgkmcnt(0)" ::: "memory"); SBAR(); MM4(B, 3);
    } else {
    s16x4 A[8];
    RD8(A, 0); asm volatile("s_waitcnt lgkmcnt(0)" ::: "memory"); SBAR(); MM4(A, 0); SBAR();
    RD8(A, 1); asm volatile("s_waitcnt lgkmcnt(0)" ::: "memory"); SBAR(); MM4(A, 1); SBAR();
    RD8(A, 2); asm volatile("s_waitcnt lgkmcnt(0)" ::: "memory"); SBAR(); MM4(A, 2); SBAR();
    RD8(A, 3); asm volatile("s_waitcnt lgkmcnt(0)" ::: "memory"); SBAR(); MM4(A, 3);
    }
#undef MM4
#undef RD8
#undef TRRD
}
template <int ND, int KROW> __device__ __forceinline__ void qk_tile(f32x16& p0, f32x16& p1, const ALAS char* Kb, const int (&kb4)[4], const bf16x8* qr) {
    bf16x8 R[3][2];
#define LDK(slot, d0) do { const ALAS char* ka = Kb + kb4[(d0) & 3] + ((d0) >> 2) * 128; R[slot][0] = *(const ALAS bf16x8*)(ka); R[slot][1] = *(const ALAS bf16x8*)(ka + 32 * KROW); } while (0)
    LDK(0, 0); LDK(1, 1); LDK(2, 2);
    p0 = f32x16{}; p1 = f32x16{};
#pragma unroll
    for (int d0 = 0; d0 < ND; ++d0) {
        SBAR();
        p0 = __builtin_amdgcn_mfma_f32_32x32x16_bf16(R[d0 % 3][0], qr[d0], p0, 0, 0, 0); p1 = __builtin_amdgcn_mfma_f32_32x32x16_bf16(R[d0 % 3][1], qr[d0], p1, 0, 0, 0);
        SBAR();
        if (d0 + 3 < ND) LDK(d0 % 3, d0 + 3);
    }
#undef LDK
}
struct Blk { const bf16_t* Q; const bf16_t* K; const bf16_t* V; bf16_t* O; long ldq, ldk, ldv, ldo; int P0, skv, W; float* mo; float* lo; long ldml; };
template <int DQK>
__device__ __forceinline__ void attn_block(const Blk& b, ALAS unsigned char* ldsp) {
    char* lds = (char*)ldsp;
    constexpr int ND = DQK / 16, KROW = DQK * 2, SHM_K = 64 * KROW, CPR = DQK / 8, NKC = (64 * CPR) / 512;
    const int tid = threadIdx.x, wid = __builtin_amdgcn_readfirstlane(tid >> 6), lane = tid & 63, r32 = lane & 31, hi = lane >> 5;
    char* V_lds = lds; char* K_lds = lds + 3 * SHM_V; float* ws = (float*)(lds + 3 * SHM_V + 3 * SHM_K) + wid * 64;
    const int lowk = b.P0 - b.W + 1; const int j_lo = lowk > 0 ? lowk / KVBLK : 0;
    int j_hi = (b.P0 + QB - 1) / KVBLK + 1; if (j_hi > b.skv / KVBLK) j_hi = b.skv / KVBLK;
    const int NT = j_hi - j_lo;
    const int qlo = b.P0 + wid * QBLK, qm = qlo + r32 - 4 * hi;
    bf16x8 qr[ND];
#pragma unroll
    for (int d0 = 0; d0 < ND; ++d0) qr[d0] = *(const bf16x8*)(b.Q + (size_t)(wid * QBLK + r32) * b.ldq + d0 * 16 + hi * 8);
    unsigned ksrc[NKC], vsrc;
#pragma unroll
    for (int i = 0; i < NKC; ++i) { const int p = (wid + 8 * i) * 1024 + lane * 16; const int row = p / KROW, cc = ((p % KROW) >> 4) ^ (row & 7); ksrc[i] = (unsigned)(row * (int)b.ldk + cc * 8); }
    { const int sub = wid * 2 + (lane >> 5); const int kk = (sub >> 2) * 8 + ((lane & 31) >> 2); const int k = (kk & ~0xC) | ((kk & 4) << 1) | ((kk & 8) >> 1);
      vsrc = (unsigned)(k * (int)b.ldv + (sub & 3) * 32 + (lane & 3) * 8); }
    const int vb0 = (int)(uintptr_t)V_lds + v_rd_base(lane);
    ALAS unsigned char* ldsl = ldsp;
#define ISSUE_K(t, bf) do { const bf16_t* kt_ = b.K + (size_t)(j_lo + (t)) * KVBLK * b.ldk; \
        _Pragma("unroll") for (int i = 0; i < NKC; ++i) __builtin_amdgcn_global_load_lds((const unsigned*)(kt_ + ksrc[i]), (ALAS unsigned*)(ldsl + 3 * SHM_V + (bf) * SHM_K + (wid + 8 * i) * 1024), 16, 0, 0); } while (0)
#define ISSUE_V(t, bf) do { const bf16_t* vt_ = b.V + (size_t)(j_lo + (t)) * KVBLK * b.ldv; \
        _Pragma("unroll") for (int i = 0; i < 2; ++i) __builtin_amdgcn_global_load_lds((const unsigned*)(vt_ + (size_t)i * 32 * b.ldv + vsrc), (ALAS unsigned*)(ldsl + (bf) * SHM_V + (wid + 8 * i) * 1024), 16, 0, 0); } while (0)
#define WAIT_BAR(N) asm volatile("s_waitcnt vmcnt(%0) lgkmcnt(0)\n\ts_barrier" :: "n"(N) : "memory")
    float m_reg = -1e30f, l_reg = 0.f; f32x16 o[4] = {}; f32x16 p0, p1;
    int kb4[4];
#pragma unroll
    for (int dd = 0; dd < 4; ++dd) kb4[dd] = KROW * r32 + ((dd * 32 + hi * 16) ^ ((r32 & 7) << 4));
#define H1(s_) do { qk_tile<ND, KROW>(p0, p1, (const ALAS char*)ldsl + 3 * SHM_V + ((s_) % 3) * SHM_K, kb4, qr); \
        const int kb_ = (j_lo + (s_)) * KVBLK; if (kb_ + KVBLK - 1 > qlo || kb_ <= qlo + QBLK - 1 - b.W) mask_tile(p0, p1, qm - kb_, (unsigned)b.W); } while (0)
#define H2(s_) do { float alpha; bf16x8 pa0, pa1, pa2, pa3; softmax_tile(p0, p1, m_reg, l_reg, alpha, pa0, pa1, pa2, pa3); \
        if (__any(alpha < 1.f)) { if (hi == 0) ws[32 + r32] = alpha; asm volatile("s_waitcnt lgkmcnt(0)" ::: "memory"); \
            _Pragma("unroll") for (int d_ = 0; d_ < 4; ++d_) _Pragma("unroll") for (int r = 0; r < 16; ++r) o[d_][r] *= ws[32 + crow(r, hi)]; } \
        SBAR(); pv_tile<(DQK == 128)>(o, vb0 + ((s_) % 3) * SHM_V, pa0, pa1, pa2, pa3); } while (0)
    ISSUE_K(0, 0); ISSUE_V(0, 0);
    if (NT > 1) { ISSUE_K(1, 1); ISSUE_V(1, 1); WAIT_BAR(NKC + 2); } else { WAIT_BAR(0); }
    if (wid < 4) {
        for (int s = 0; s < NT; ++s) { const bool more2 = s + 2 < NT;
            if (more2) ISSUE_K(s + 2, (s + 2) % 3);
            H1(s);
            if (more2) WAIT_BAR(2 * NKC + 2); else WAIT_BAR(0);
            if (more2) ISSUE_V(s + 2, (s + 2) % 3);
            H2(s);
            if (more2) WAIT_BAR(NKC + 4); else WAIT_BAR(0); }
        WAIT_BAR(0);
    } else {
        if (NT > 2) { ISSUE_K(2, 2); WAIT_BAR(2 * NKC + 2); } else { WAIT_BAR(0); }
        for (int s = 0; s < NT; ++s) { const bool more2 = s + 2 < NT, more3 = s + 3 < NT;
            if (more2) ISSUE_V(s + 2, (s + 2) % 3);
            H1(s);
            if (more2) WAIT_BAR(NKC + 4); else WAIT_BAR(0);
            if (more3) ISSUE_K(s + 3, s % 3);
            H2(s);
            if (more3) WAIT_BAR(2 * NKC + 2); else WAIT_BAR(0); }
    }
#undef H1
#undef H2
#undef ISSUE_K
#undef ISSUE_V
#undef WAIT_BAR
    if (hi == 0) { ws[r32] = l_reg; if (b.mo) { b.mo[(size_t)(wid * QBLK + r32) * b.ldml] = m_reg; b.lo[(size_t)(wid * QBLK + r32) * b.ldml] = l_reg; } }
    asm volatile("s_waitcnt lgkmcnt(0)" ::: "memory");
    bf16_t* Ow = b.O + (size_t)(wid * QBLK) * b.ldo;
#pragma unroll
    for (int r = 0; r < 16; ++r) { const int orow = crow(r, hi); const float rl = __builtin_amdgcn_rcpf(ws[orow]);
#pragma unroll
        for (int d0 = 0; d0 < 4; ++d0) { const float v = o[d0][r] * rl; const float vn = __shfl_xor(v, 1);
            if ((r32 & 1) == 0) *(unsigned*)(Ow + (size_t)orow * b.ldo + d0 * 32 + r32) = cvtpk(v, vn); } }
    __syncthreads();
}
#undef SBAR
}

#define LAS __attribute__((address_space(3)))
typedef unsigned short bf16;
typedef unsigned v4u __attribute__((ext_vector_type(4)));
typedef unsigned v2u __attribute__((ext_vector_type(2)));
typedef float f32x4 __attribute__((ext_vector_type(4)));
constexpr int NWAVES = 8;
constexpr int BATCH = 2, SEQ = 8192, M = BATCH * SEQ, DM = 2048, DFF = 5632, DIN_T = 14336;
constexpr int NPH = 14;
constexpr size_t MiB = 1u << 20;
constexpr size_t WS_SS = 0;
constexpr size_t WS_ML = 1 * MiB;
constexpr size_t WS_WGU = 8 * MiB, WS_WD = 52 * MiB, WS_WIN = 74 * MiB, WS_WUQ = 130 * MiB, WS_WUKV = WS_WUQ + 3 * MiB / 2, WS_WBRM = WS_WUKV + 1 * MiB,
                 WS_WBRD = WS_WBRM + 4 * MiB, WS_WO = WS_WBRD + 4 * MiB, WS_WPG = WS_WO + 8 * MiB, WS_WPP = WS_WPG + 8 * MiB;
constexpr size_t WS_XB = 158 * MiB;
constexpr size_t WS_ODIL = 222 * MiB;
constexpr size_t WS_PB = 254 * MiB;
constexpr size_t WS_R = 262 * MiB;
constexpr size_t WS_END = 550 * MiB;
constexpr size_t R_SMALL = WS_R, R_GATES = WS_R + 32 * MiB, R_Q = WS_R + 160 * MiB, R_K = WS_R + 208 * MiB, R_OMLA = WS_R + 256 * MiB, R_MERGED = R_Q, R_T = WS_R;
constexpr int RING_BYTES = 131072, LDS_BYTES = 147456;
constexpr float LOG2E = 1.4426950408889634f;

struct Args { const void* in[27]; float* out; unsigned char* ws; int ph_lo, ph_hi; };

__device__ __forceinline__ float wave_sum(float v) {
#pragma unroll
    for (int o = 1; o < 64; o <<= 1) v += __shfl_xor(v, o);
    return v;
}
__device__ __forceinline__ unsigned f2bf(float f) { unsigned u = __builtin_bit_cast(unsigned, f); return (u + 0x7fffu + ((u >> 16) & 1u)) >> 16; }
__device__ __forceinline__ unsigned pk2(float lo, float hi) { return f2bf(lo) | (f2bf(hi) << 16); }
__device__ __forceinline__ float bflo(unsigned w) { return __uint_as_float(w << 16); }
__device__ __forceinline__ float bfhi(unsigned w) { return __uint_as_float(w & 0xffff0000u); }
template <int MAP> __device__ __forceinline__ int drow0(int n0) {
    if (MAP == 1) return (n0 >> 7) * 256 + (n0 & 127);
    if (MAP == 2) return (n0 >> 7) * 256 + 128 + (n0 & 127);
    if (MAP == 3) return n0 < 832 ? 9216 + n0 : (n0 < 10048 ? n0 - 832 : 10240 + (n0 - 10048));
    return n0;
}
template <int MAP> __device__ __forceinline__ void xpose_item(const float* W, int K, int N, const float* gain, bf16* WT, LAS float* scr, int item, int lane) {
    const int nblk = N / 32, kb = item / nblk, nb = item % nblk, k0 = 64 * kb, n0 = 32 * nb;
    float tv[32];
#pragma unroll
    for (int i = 0; i < 32; ++i) { const int kk = 2 * i + (lane >> 5); tv[i] = W[(size_t)(k0 + kk) * N + n0 + (lane & 31)]; }
#pragma unroll
    for (int i = 0; i < 32; ++i) { const int kk = 2 * i + (lane >> 5); const float gv = gain ? gain[k0 + kk] : 1.f; scr[kk * 33 + (lane & 31)] = tv[i] * gv; }
    asm volatile("s_waitcnt lgkmcnt(0)" ::: "memory");
    const int c = lane & 7, d0 = drow0<MAP>(n0);
#pragma unroll
    for (int j = 0; j < 4; ++j) { const int n = (lane >> 3) + 8 * j; const LAS float* s = scr + (8 * c) * 33 + n;
        v4u o; o.x = pk2(s[0 * 33], s[1 * 33]); o.y = pk2(s[2 * 33], s[3 * 33]); o.z = pk2(s[4 * 33], s[5 * 33]); o.w = pk2(s[6 * 33], s[7 * 33]);
        *(v4u*)(WT + (size_t)(d0 + n) * K + k0 + 8 * c) = o; }
    asm volatile("s_waitcnt lgkmcnt(0)" ::: "memory");
}
struct XJob { const float* W; const float* gain; bf16* WT; int K, N, map; };
__device__ __forceinline__ void xpose_run(const XJob& j, LAS float* scr, int gw, int NGW, int lane, int& base) {
    const int items = (j.K / 64) * (j.N / 32);
    int first = gw - (base % NGW); if (first < 0) first += NGW;
    for (int it = first; it < items; it += NGW) {
        if (j.map == 0) xpose_item<0>(j.W, j.K, j.N, j.gain, j.WT, scr, it, lane);
        else if (j.map == 1) xpose_item<1>(j.W, j.K, j.N, j.gain, j.WT, scr, it, lane);
        else if (j.map == 2) xpose_item<2>(j.W, j.K, j.N, j.gain, j.WT, scr, it, lane);
        else xpose_item<3>(j.W, j.K, j.N, j.gain, j.WT, scr, it, lane);
    }
    base += items;
}
__device__ __forceinline__ void sincos_rev(float ang, float& s, float& c) {
    double rv = (double)ang * 0.15915494309189535; rv -= __builtin_rint(rv); const float f = (float)rv;
    s = __builtin_amdgcn_sinf(f); c = __builtin_amdgcn_cosf(f);
}

__global__ void __launch_bounds__(NWAVES * 64, 2) mk_fwd(Args args) {
    extern __shared__ __attribute__((aligned(16))) unsigned char lds[];
    const int wave = __builtin_amdgcn_readfirstlane((int)threadIdx.x >> 6);
#define tid ((int)threadIdx.x)
#define lane ((int)threadIdx.x & 63)
    const int G = gridDim.x, bx = blockIdx.x;
    const int gw = bx * NWAVES + wave, NGW = G * NWAVES;
    unsigned char* ws = args.ws;
    const float* x = (const float*)args.in[0]; const float* pin = (const float*)args.in[1]; const int* positions = (const int*)args.in[2];
    const float* g_ffn1 = (const float*)args.in[3]; const float* w1_gate = (const float*)args.in[4]; const float* w1_up = (const float*)args.in[5]; const float* w1_down = (const float*)args.in[6];
    const float* g_mix = (const float*)args.in[7]; const float* w_in = (const float*)args.in[8]; const float* g_cq = (const float*)args.in[9]; const float* w_uq = (const float*)args.in[10];
    const float* g_ckv = (const float*)args.in[11]; const float* w_ukv = (const float*)args.in[12]; const float* g_q_mla = (const float*)args.in[13]; const float* g_k_mla = (const float*)args.in[14];
    const float* g_q_dil = (const float*)args.in[15]; const float* g_k_dil = (const float*)args.in[16]; const float* w_br_mla = (const float*)args.in[17]; const float* w_br_dil = (const float*)args.in[18];
    const float* w_o = (const float*)args.in[19]; const float* g_ffn2 = (const float*)args.in[20]; const float* w2_gate = (const float*)args.in[21]; const float* w2_up = (const float*)args.in[22];
    const float* w2_down = (const float*)args.in[23]; const float* g_ple = (const float*)args.in[24]; const float* w_ple_gate = (const float*)args.in[25]; const float* w_ple_proj = (const float*)args.in[26];
    float* out = args.out;
    float* ss0 = (float*)(ws + WS_SS); float* ss1 = ss0 + M; float* ss2 = ss0 + 2 * M; float* ss3 = ss0 + 3 * M; float* ss_cq = ss0 + 4 * M; float* ss_ckv = ss0 + 5 * M;
    float* mlm = (float*)(ws + WS_ML); float* mll = mlm + 3 * M * 8;
    bf16* Wgu = (bf16*)(ws + WS_WGU); bf16* Wd = (bf16*)(ws + WS_WD); bf16* Win = (bf16*)(ws + WS_WIN); bf16* Wuq = (bf16*)(ws + WS_WUQ); bf16* Wukv = (bf16*)(ws + WS_WUKV);
    bf16* Wbrm = (bf16*)(ws + WS_WBRM); bf16* Wbrd = (bf16*)(ws + WS_WBRD); bf16* Wo = (bf16*)(ws + WS_WO); bf16* Wpg = (bf16*)(ws + WS_WPG); bf16* Wpp = (bf16*)(ws + WS_WPP);
    bf16* xb = (bf16*)(ws + WS_XB); bf16* kvraw = xb; bf16* odil = (bf16*)(ws + WS_ODIL); bf16* pb = (bf16*)(ws + WS_PB);
    bf16* act = (bf16*)(ws + WS_R); bf16* projd = (bf16*)(ws + WS_R); bf16* smallb = (bf16*)(ws + R_SMALL); bf16* gates = (bf16*)(ws + R_GATES);
    bf16* Qm = (bf16*)(ws + R_Q); bf16* Km = (bf16*)(ws + R_K); bf16* omla = (bf16*)(ws + R_OMLA); bf16* merged = (bf16*)(ws + R_MERGED); bf16* Tb = (bf16*)(ws + R_T);
    LAS unsigned char* ldsl = (LAS unsigned char*)lds;
    LAS float* scr = (LAS float*)(ldsl + wave * 16384);
    const int lo = args.ph_lo, hi = args.ph_hi;
#ifndef PH_MASK
#define PH_MASK 0xffff
#endif
#define IN(k) ((((PH_MASK) >> (k)) & 1) && lo <= (k) && (k) < hi)
#define SEAM(k) do { if (IN(k) && IN((k) + 1)) { cg::this_grid().sync(); } } while (0)

    if (IN(0)) {
        int base = 0;
        { XJob j{w1_gate, g_ffn1, Wgu, DM, DFF, 1}; xpose_run(j, scr, gw, NGW, lane, base); }
        { XJob j{w1_up, g_ffn1, Wgu, DM, DFF, 2}; xpose_run(j, scr, gw, NGW, lane, base); }
        { XJob j{w1_down, nullptr, Wd, DFF, DM, 0}; xpose_run(j, scr, gw, NGW, lane, base); }
        { XJob j{w_in, g_mix, Win, DM, 14144, 3}; xpose_run(j, scr, gw, NGW, lane, base); }
        { XJob j{w_uq, g_cq, Wuq, 512, 1536, 0}; xpose_run(j, scr, gw, NGW, lane, base); }
        { XJob j{w_ukv, g_ckv, Wukv, 256, 2048, 0}; xpose_run(j, scr, gw, NGW, lane, base); }
        { XJob j{w_br_mla, nullptr, Wbrm, 1024, DM, 0}; xpose_run(j, scr, gw, NGW, lane, base); }
        { XJob j{w_br_dil, nullptr, Wbrd, 1024, DM, 0}; xpose_run(j, scr, gw, NGW, lane, base); }
        { XJob j{w_o, nullptr, Wo, DM, DM, 0}; xpose_run(j, scr, gw, NGW, lane, base); }
        { XJob j{w_ple_gate, g_ple, Wpg, DM, DM, 0}; xpose_run(j, scr, gw, NGW, lane, base); }
        { XJob j{w_ple_proj, nullptr, Wpp, 256, DM, 0}; xpose_run(j, scr, gw, NGW, lane, base); }
        for (int m = gw; m < M; m += NGW) {
            const f32x4* xr = (const f32x4*)(x + (size_t)m * DM) + lane; f32x4 v[8]; float s = 0.f;
#pragma unroll
            for (int j = 0; j < 8; ++j) { v[j] = xr[64 * j]; s += (v[j].x * v[j].x + v[j].y * v[j].y) + (v[j].z * v[j].z + v[j].w * v[j].w); }
            s = wave_sum(s); if (lane == 0) ss0[m] = s;
            v2u* o8 = (v2u*)(xb + (size_t)m * DM) + lane;
#pragma unroll
            for (int j = 0; j < 8; ++j) o8[64 * j] = (v2u){pk2(v[j].x, v[j].y), pk2(v[j].z, v[j].w)};
            const f32x4 pv = *((const f32x4*)(pin + (size_t)m * 256) + lane);
            *((v2u*)(pb + (size_t)m * 256) + lane) = (v2u){pk2(pv.x, pv.y), pk2(pv.z, pv.w)};
        }
        for (int i = bx * 512 + tid; i < 5 * M; i += G * 512) ss1[i] = 0.f;
    }
    SEAM(0);
    if (IN(1)) {
        pg8::Gemm g{xb, Wgu, M, 2 * DFF, DM, DM, DM}; pg8::StaticOrder S; S.init(M, 2 * DFF, G, bx);
        pg8::EpiSwiGLU E{act, DFF, ss0, 1.f / DM};
        pg8::gemm_phase<pg8::EpiSwiGLU, pg8::StaticOrder, true, true>(ldsl, g, S, E);
    }
    SEAM(1);
    if (IN(2)) {
        pg8::Gemm g{act, Wd, M, DM, DFF, DFF, DFF}; pg8::StaticOrder S; S.init(M, DM, G, bx);
        pg8::EpiResid E{x, out, xb, ss1, 0.5f};
        pg8::gemm_phase<pg8::EpiResid, pg8::StaticOrder, true, true>(ldsl, g, S, E);
    }
    SEAM(2);
    if (IN(3)) {
        pg8::Gemm g{xb, Win, M, 9216, DM, DM, DM}; pg8::StaticOrder S; S.init(M, 9216, G, bx);
        pg8::EpiScale<0> E{projd, 9216, ss1, 1.f / DM};
        pg8::gemm_phase<pg8::EpiScale<0>, pg8::StaticOrder, true, true>(ldsl, g, S, E);
    }
    SEAM(3);
    if (IN(4)) {
        int base = 0;
        { XJob j{w2_gate, g_ffn2, Wgu, DM, DFF, 1}; xpose_run(j, scr, gw, NGW, lane, base); }
        { XJob j{w2_up, g_ffn2, Wgu, DM, DFF, 2}; xpose_run(j, scr, gw, NGW, lane, base); }
        { XJob j{w2_down, nullptr, Wd, DFF, DM, 0}; xpose_run(j, scr, gw, NGW, lane, base); }
        const int i16 = lane & 15, vsel = lane >> 4;
        for (int tok = gw; tok < M; tok += NGW) {
            const float pos = (float)positions[tok];
            float cs[8], sn[8];
#pragma unroll
            for (int e = 0; e < 8; ++e) { const int jj = 8 * (i16 & 1) + e; const float inv = exp2f(-(float)jj * (1.f / 16.f) * 18.931568569324174f); sincos_rev(pos * inv, sn[e], cs[e]); }
            bf16* tp = projd + (size_t)tok * 9216 + vsel * 128 + i16 * 8;
            v4u wv[12];
#pragma unroll
            for (int c = 0; c < 12; ++c) wv[c] = *(const v4u*)(tp + (c >> 2) * 3072 + ((c >> 1) & 1) * 1024 + (c & 1) * 512);
#pragma unroll
            for (int c = 0; c < 12; ++c) { const int gi = c >> 2, qk = (c >> 1) & 1;
                const float* gain = (qk ? g_k_dil : g_q_dil) + gi * 128 + i16 * 8;
                const f32x4 ga = *(const f32x4*)gain, gb = *(const f32x4*)(gain + 4);
                const float gsc = qk ? 1.f : 0.08838834764831845f * LOG2E;
                const v4u w = wv[c]; float v[8] = {bflo(w.x), bfhi(w.x), bflo(w.y), bfhi(w.y), bflo(w.z), bfhi(w.z), bflo(w.w), bfhi(w.w)};
                float s = 0.f;
#pragma unroll
                for (int e = 0; e < 8; ++e) s += v[e] * v[e];
                s += __shfl_xor(s, 1); s += __shfl_xor(s, 2); s += __shfl_xor(s, 4); s += __shfl_xor(s, 8);
                const float r = rsqrtf(s * (1.f / 128.f) + 1e-6f);
#pragma unroll
                for (int e = 0; e < 8; ++e) v[e] *= r * (e < 4 ? ga[e] : gb[e - 4]);
#pragma unroll
                for (int e = 0; e < 8; ++e) { const float pr = __shfl_xor(v[e], 2); if (i16 < 4) v[e] = (i16 < 2) ? v[e] * cs[e] - pr * sn[e] : v[e] * cs[e] + pr * sn[e]; }
                v4u o; o.x = pk2(v[0] * gsc, v[1] * gsc); o.y = pk2(v[2] * gsc, v[3] * gsc); o.z = pk2(v[4] * gsc, v[5] * gsc); o.w = pk2(v[6] * gsc, v[7] * gsc);
                *(v4u*)(tp + (c >> 2) * 3072 + ((c >> 1) & 1) * 1024 + (c & 1) * 512) = o; }
        }
    }
    SEAM(4);
    if (IN(5)) {
        for (int it = bx; it < 1536; it += G) {
            const int gi = it / 512, r1 = it % 512, bb = r1 / 256, r2 = r1 % 256, h = r2 / 32, nb = r2 % 32;
            const int dil = gi == 0 ? 1 : (gi == 1 ? 4 : 16), Lg = SEQ / dil, bpp = Lg / 256, ph = nb / bpp, ib = nb % bpp;
            bf16* seq0 = projd + ((size_t)bb * SEQ + ph) * 9216 + gi * 3072 + h * 128;
            att::Blk b; b.ldq = b.ldk = b.ldv = b.ldo = (long)dil * 9216; b.P0 = ib * 256; b.skv = Lg; b.W = 129;
            b.Q = seq0 + (size_t)b.P0 * b.ldq; b.O = seq0 + (size_t)b.P0 * b.ldq; b.K = seq0 + 1024; b.V = seq0 + 2048;
            const size_t tok0 = (size_t)bb * SEQ + ph + (size_t)dil * b.P0;
            b.mo = mlm + ((size_t)gi * M + tok0) * 8 + h; b.lo = mll + ((size_t)gi * M + tok0) * 8 + h; b.ldml = (long)dil * 8;
            att::attn_block<128>(b, ldsl);
        }
    }
    SEAM(5);
    if (IN(6)) {
        for (int i = bx * 512 + tid; i < 2 * M; i += G * 512) ss_cq[i] = 0.f;
        for (int i = bx * 512 + tid; i < M * 8 * 16; i += G * 512) { const int tok = i >> 7, h = (i >> 4) & 7, c = i & 15;
            float mg[3], lg[3];
#pragma unroll
            for (int gi = 0; gi < 3; ++gi) { mg[gi] = mlm[((size_t)gi * M + tok) * 8 + h]; lg[gi] = mll[((size_t)gi * M + tok) * 8 + h]; }
            const float mx = fmaxf(fmaxf(mg[0], mg[1]), mg[2]); float wsum = 0.f, wg[3];
#pragma unroll
            for (int gi = 0; gi < 3; ++gi) { wg[gi] = lg[gi] * exp2f(mg[gi] - mx); wsum += wg[gi]; }
            const float iw = 1.f / wsum; float a[8] = {0.f, 0.f, 0.f, 0.f, 0.f, 0.f, 0.f, 0.f};
#pragma unroll
            for (int gi = 0; gi < 3; ++gi) { const v4u w = *(const v4u*)(projd + (size_t)tok * 9216 + gi * 3072 + h * 128 + c * 8); const float f = wg[gi] * iw;
                a[0] += f * bflo(w.x); a[1] += f * bfhi(w.x); a[2] += f * bflo(w.y); a[3] += f * bfhi(w.y); a[4] += f * bflo(w.z); a[5] += f * bfhi(w.z); a[6] += f * bflo(w.w); a[7] += f * bfhi(w.w); }
            v4u o; o.x = pk2(a[0], a[1]); o.y = pk2(a[2], a[3]); o.z = pk2(a[4], a[5]); o.w = pk2(a[6], a[7]);
            *(v4u*)(odil + (size_t)tok * 1024 + h * 128 + c * 8) = o; }
    }
    SEAM(6);
    if (IN(7)) {
        pg8::Gemm g{xb, Win + (size_t)9216 * DM, M, 5120, DM, DM, DM}; pg8::StaticOrder S; S.init(M, 5120, G, bx);
        pg8::EpiP3b E{smallb, gates, ss1, ss_cq, ss_ckv};
        pg8::gemm_phase<pg8::EpiP3b, pg8::StaticOrder, true, true>(ldsl, g, S, E);
    }
    SEAM(7);
    if (IN(8)) {
        { pg8::Gemm g{smallb, Wuq, M, 1536, 512, 1024, 512}; pg8::StaticOrder S; S.init(M, 1536, G, bx);
          pg8::EpiScale<0> E{Qm, 1536, ss_cq, 1.f / 512.f};
          pg8::gemm_phase<pg8::EpiScale<0>, pg8::StaticOrder, true, true>(ldsl, g, S, E); }
        { pg8::Gemm g{smallb + 512, Wukv, M, 2048, 256, 1024, 256}; pg8::StaticOrder S; S.init(M, 2048, G, bx);
          pg8::EpiScale<0> E{kvraw, 2048, ss_ckv, 1.f / 256.f};
          pg8::gemm_phase<pg8::EpiScale<0>, pg8::StaticOrder, true, true>(ldsl, g, S, E); }
    }
    SEAM(8);
    if (IN(9)) {
        const int jj = lane & 31; const float inv = exp2f(-(float)jj * (1.f / 32.f) * 18.931568569324174f);
        const float gqn0 = g_q_mla[2 * lane], gqn1 = g_q_mla[2 * lane + 1], gqr = g_q_mla[128 + lane];
        const float gkn0 = g_k_mla[2 * lane], gkn1 = g_k_mla[2 * lane + 1], gkr = g_k_mla[128 + lane];
        const float qsc = 0.07216878364870323f * LOG2E;
        for (int tok = gw; tok < M; tok += NGW) {
            float sn, cs; sincos_rev((float)positions[tok] * inv, sn, cs);
            const float krv = bflo((unsigned)smallb[(size_t)tok * 1024 + 768 + lane]);
            bf16* qt = Qm + (size_t)tok * 1536; const bf16* kt = kvraw + (size_t)tok * 2048; bf16* ko = Km + (size_t)tok * 1536;
            unsigned qw[8], kw[8]; unsigned short qrr[8];
#pragma unroll
            for (int h = 0; h < 8; ++h) { qw[h] = *(const unsigned*)(qt + h * 192 + 2 * lane); qrr[h] = qt[h * 192 + 128 + lane]; kw[h] = *(const unsigned*)(kt + h * 256 + 2 * lane); }
#pragma unroll
            for (int h = 0; h < 8; ++h) {
                { float a0 = bflo(qw[h]), a1 = bfhi(qw[h]), ar = bflo((unsigned)qrr[h]);
                  const float s = wave_sum(a0 * a0 + a1 * a1 + ar * ar); const float r = rsqrtf(s * (1.f / 192.f) + 1e-6f);
                  a0 *= r * gqn0; a1 *= r * gqn1; ar *= r * gqr; const float pr = __shfl_xor(ar, 32); ar = lane < 32 ? ar * cs - pr * sn : ar * cs + pr * sn;
                  *(unsigned*)(qt + h * 192 + 2 * lane) = pk2(a0 * qsc, a1 * qsc); qt[h * 192 + 128 + lane] = (bf16)f2bf(ar * qsc); }
                { float a0 = bflo(kw[h]), a1 = bfhi(kw[h]), ar = krv;
                  const float s = wave_sum(a0 * a0 + a1 * a1 + ar * ar); const float r = rsqrtf(s * (1.f / 192.f) + 1e-6f);
                  a0 *= r * gkn0; a1 *= r * gkn1; ar *= r * gkr; const float pr = __shfl_xor(ar, 32); ar = lane < 32 ? ar * cs - pr * sn : ar * cs + pr * sn;
                  *(unsigned*)(ko + h * 192 + 2 * lane) = pk2(a0, a1); ko[h * 192 + 128 + lane] = (bf16)f2bf(ar); }
            }
        }
    }
    SEAM(9);
    if (IN(10)) {
        for (int it0 = bx; it0 < 256; it0 += G) { const int it = (G == 256) ? ((((it0 & 7) * 2 + (it0 >> 7)) << 4) | ((it0 >> 3) & 15)) : it0;
            const int bh = it >> 4, xq = it & 15, bb = bh >> 3, h = bh & 7;
            for (int ps = 0; ps < 2; ++ps) { const int qb = ps ? 31 - xq : xq;
                att::Blk b; b.ldq = 1536; b.ldk = 1536; b.ldv = 2048; b.ldo = 1024; b.P0 = qb * 256; b.skv = SEQ; b.W = 1 << 30;
                b.Q = Qm + ((size_t)bb * SEQ + b.P0) * 1536 + h * 192; b.K = Km + (size_t)bb * SEQ * 1536 + h * 192; b.V = kvraw + (size_t)bb * SEQ * 2048 + h * 256 + 128;
                b.O = omla + ((size_t)bb * SEQ + b.P0) * 1024 + h * 128; b.mo = nullptr; b.lo = nullptr; b.ldml = 0;
                att::attn_block<192>(b, ldsl); } }
    }
    SEAM(10);
    if (IN(11)) {
        { pg8::Gemm g{omla, Wbrm, M, DM, 1024, 1024, 1024}; pg8::StaticOrder S; S.init(M, DM, G, bx);
          pg8::EpiBr<true> E{merged, gates};
          pg8::gemm_phase<pg8::EpiBr<true>, pg8::StaticOrder, true, true>(ldsl, g, S, E); }
        { pg8::Gemm g{odil, Wbrd, M, DM, 1024, 1024, 1024}; pg8::StaticOrder S; S.init(M, DM, G, bx);
          pg8::EpiBr<false> E{merged, gates};
          pg8::gemm_phase<pg8::EpiBr<false>, pg8::StaticOrder, true, true>(ldsl, g, S, E); }
    }
    SEAM(11);
    if (IN(12)) {
        pg8::Gemm g{merged, Wo, M, DM, DM, DM, DM}; pg8::StaticOrder S; S.init(M, DM, G, bx);
        pg8::EpiResid E{out, out, xb, ss2, 1.f};
        pg8::gemm_phase<pg8::EpiResid, pg8::StaticOrder, true, true>(ldsl, g, S, E);
    }
    SEAM(12);
    if (IN(13)) {
        pg8::Gemm g{xb, Wgu, M, 2 * DFF, DM, DM, DM}; pg8::StaticOrder S; S.init(M, 2 * DFF, G, bx);
        pg8::EpiSwiGLU E{act, DFF, ss2, 1.f / DM};
        pg8::gemm_phase<pg8::EpiSwiGLU, pg8::StaticOrder, true, true>(ldsl, g, S, E);
    }
    SEAM(13);
    if (IN(14)) {
        pg8::Gemm g{act, Wd, M, DM, DFF, DFF, DFF}; pg8::StaticOrder S; S.init(M, DM, G, bx);
        pg8::EpiResid E{out, out, xb, ss3, 0.5f};
        pg8::gemm_phase<pg8::EpiResid, pg8::StaticOrder, true, true>(ldsl, g, S, E);
    }
    SEAM(14);
    if (IN(15)) {
        { pg8::Gemm g{pb, Wpp, M, DM, 256, 256, 256}; pg8::StaticOrder S; S.init(M, DM, G, bx);
          pg8::EpiScale<0> E{Tb, DM, nullptr, 0.f};
          pg8::gemm_phase<pg8::EpiScale<0>, pg8::StaticOrder, true, true>(ldsl, g, S, E); }
        { pg8::Gemm g{xb, Wpg, M, DM, DM, DM, DM}; pg8::StaticOrder S; S.init(M, DM, G, bx);
          pg8::EpiPle E{out, Tb, ss3};
          pg8::gemm_phase<pg8::EpiPle, pg8::StaticOrder, true, true>(ldsl, g, S, E); }
    }
#undef IN
#undef SEAM
#undef tid
#undef lane
}
constexpr int N_PHASES = 16;

extern "C" void kernel_launch(void* const* d_in, const int* in_sizes, int n_in, void* d_out, int out_size, void* d_ws, size_t ws_size, hipStream_t stream) {
    static int grid = 0;
    if (grid == 0) {
        if (n_in != 27 || out_size != M * DM || ws_size < WS_END) { fprintf(stderr, "kernel_launch: unexpected shapes / workspace (n_in %d out %d ws %zu)\n", n_in, out_size, ws_size); grid = -1; return; }
        int dev = 0, cus = 0, per_cu = 0;
        (void)hipGetDevice(&dev); (void)hipDeviceGetAttribute(&cus, hipDeviceAttributeMultiprocessorCount, dev);
        if (hipFuncSetAttribute((const void*)mk_fwd, hipFuncAttributeMaxDynamicSharedMemorySize, LDS_BYTES) != hipSuccess) { fprintf(stderr, "hipFuncSetAttribute failed\n"); grid = -1; return; }
        if (hipOccupancyMaxActiveBlocksPerMultiprocessor(&per_cu, (const void*)mk_fwd, NWAVES * 64, LDS_BYTES) != hipSuccess || per_cu < 1) { fprintf(stderr, "occupancy query: %d\n", per_cu); per_cu = 1; }
        (void)hipGetLastError();
        grid = cus > 0 ? cus : 256;
    }
    if (grid < 0) return;
    Args a{};
    for (int i = 0; i < 27; ++i) a.in[i] = d_in[i];
    a.out = (float*)d_out; a.ws = (unsigned char*)d_ws;
#if MK_PER_PHASE
#ifndef DUP_LO
#define DUP_LO 0
#define DUP_HI 0
#define DUP_N 0
#endif
    for (int p = 0; p < N_PHASES; ++p) { a.ph_lo = p; a.ph_hi = p + 1; hipLaunchKernelGGL(mk_fwd, dim3(grid), dim3(NWAVES * 64), LDS_BYTES, stream, a);
        if (p == DUP_HI - 1) for (int rep = 0; rep < DUP_N; ++rep) for (int q = DUP_LO; q < DUP_HI; ++q) { a.ph_lo = q; a.ph_hi = q + 1; hipLaunchKernelGGL(mk_fwd, dim3(grid), dim3(NWAVES * 64), LDS_BYTES, stream, a); } }
#else
    a.ph_lo = 0; a.ph_hi = N_PHASES;
    void* kargs[] = {&a};
    hipError_t e = hipLaunchCooperativeKernel((const void*)mk_fwd, dim3(grid), dim3(NWAVES * 64), kargs, LDS_BYTES, stream);
    if (e != hipSuccess) fprintf(stderr, "cooperative launch failed: %s (grid %d)\n", hipGetErrorString(e), grid);
#endif
}
```

```cpp
#include <hip/hip_runtime.h>
#include <hip/hip_cooperative_groups.h>
#include <cstdio>
#include <cstdint>
namespace cg = cooperative_groups;

#ifndef MK_PER_PHASE
#define MK_PER_PHASE 0
#endif

namespace pg8 {
#define PG8_LAS __attribute__((address_space(3)))
typedef unsigned short bf16_t;
typedef short bf16x8 __attribute__((ext_vector_type(8)));
typedef float f32x4 __attribute__((ext_vector_type(4)));
typedef unsigned u32x4 __attribute__((ext_vector_type(4)));
constexpr int BM = 256, BK = 64, HALF = 128, HTB = HALF * BK * 2  , STAGE_BYTES = 8 * HTB, NXCD = 8, WGM = 8;

__host__ __device__ __forceinline__ int lds_byte(int r, int c) { const int st = (r >> 4) * 2 + (c >> 5), rr = r & 15, cc = c & 31, ob = rr * 64 + cc * 2; return st * 1024 + (ob ^ (((ob >> 9) & 1) << 5)); }
__host__ __device__ __forceinline__ void stage_rc(int b, int& R, int& C) { const int st = b / 1024, sb = b % 1024, swz = sb ^ (((sb >> 9) & 1) << 5); R = (st >> 1) * 16 + swz / 64; C = (st & 1) * 32 + (swz % 64) / 2; }
__host__ __device__ __forceinline__ int perm32(int rho) { const int n = rho >> 4, i = rho & 15; return 8 * (i >> 2) + 4 * n + (i & 3); }

struct Unit { int pm, pn, k0, nk, part; };
struct Gemm { const bf16_t* A; const bf16_t* Bt; int M, N, K, lda, ldb; const bf16_t* A2; const bf16_t* Bt2; };

struct StaticOrder {
    static constexpr bool SPLIT = false, CHAIN = false;
    int nM, nN, nwg, G, c, ntk; float* scratch;
    __host__ __device__ __forceinline__ void init(int M, int N, int G_, int c_, int K_ = 0) { nM = M / BM; nN = N / BM; nwg = nM * nN; G = G_; c = c_; ntk = K_ / BK; scratch = nullptr; }
    __host__ __device__ __forceinline__ bool next(int i, Unit& u) const {
        const long L = (long)i * G + c; if (L >= nwg) return false;
        int wgid = (int)L; { const int q = nwg / NXCD, r = nwg % NXCD, xcd = wgid % NXCD, off = wgid / NXCD; wgid = (xcd < r ? xcd * (q + 1) : r * (q + 1) + (xcd - r) * q) + off; }
        const int nig = WGM * nN, gid = wgid / nig, fm = gid * WGM, gsz = (nM - fm) < WGM ? (nM - fm) : WGM;
        u.pm = fm + ((wgid % nig) % gsz); u.pn = (wgid % nig) / gsz; u.k0 = 0; u.nk = ntk; u.part = 0; return true;
    }
    __device__ __forceinline__ void a_ready(const Unit&) const {}
    __device__ __forceinline__ void done(const Unit&) const {}
};


struct SplitOrder {
    static constexpr bool SPLIT = false, CHAIN = false;
    StaticOrder b; int n, lvl; float* scratch;
    __device__ __forceinline__ void init(int M, int N, int K, int G_, int c_, int lvl_, float* scr) { b.init(M, N, G_, c_, K); scratch = scr; lvl = lvl_; n = (b.nwg - c_ + G_ - 1) / G_; if (n < 0) n = 0; if (n == 0 || (b.ntk % 8) != 0) lvl = 0; }
    __device__ __forceinline__ bool next(int i, Unit& u) const {
        if (lvl == 0) return b.next(i, u);
        if (i == 0) { b.next(0, u); u.nk = lvl * (b.ntk / 4); u.part = 1; return true; }
        if (i < n) return b.next(i, u);
        if (i == n) { b.next(0, u); u.k0 = lvl * (b.ntk / 4); u.nk = b.ntk - u.k0; u.part = 2; return true; }
        return false;
    }
    __device__ __forceinline__ void a_ready(const Unit&) const {}
    __device__ __forceinline__ void done(const Unit&) const {}
};

struct ChainOrder {
    static constexpr bool SPLIT = false, CHAIN = true;
    StaticOrder b; float* scratch;
    __device__ __forceinline__ void init(int M, int N, int K, int G_, int c_) { b.init(M, N, G_, c_, K); scratch = nullptr; }
    __device__ __forceinline__ bool next(int i, Unit& u) const { if (!b.next(i >> 1, u)) return false; u.part = 4 + (i & 1); return true; }
    __device__ __forceinline__ void a_ready(const Unit&) const {}
    __device__ __forceinline__ void done(const Unit&) const {}
};
__device__ __forceinline__ unsigned cvt_pk_bf16(float lo, float hi) { unsigned r; asm volatile("v_cvt_pk_bf16_f32 %0, %1, %2" : "=v"(r) : "v"(lo), "v"(hi)); return r; }
__device__ __forceinline__ float bf_lo(unsigned w) { return __uint_as_float(w << 16); }
__device__ __forceinline__ float bf_hi(unsigned w) { return __uint_as_float(w & 0xffff0000u); }
__device__ __forceinline__ float sigm(float v) { return __builtin_amdgcn_rcpf(1.f + __builtin_amdgcn_exp2f(-1.4426950408889634f * v)); }
__device__ __forceinline__ u32x4 pack8(f32x4 a, f32x4 b) { u32x4 w; w.x = cvt_pk_bf16(a[0], a[1]); w.y = cvt_pk_bf16(a[2], a[3]); w.z = cvt_pk_bf16(b[0], b[1]); w.w = cvt_pk_bf16(b[2], b[3]); return w; }
__device__ __forceinline__ void unpack8(u32x4 w, f32x4& a, f32x4& b) { a = (f32x4){bf_lo(w.x), bf_hi(w.x), bf_lo(w.y), bf_hi(w.y)}; b = (f32x4){bf_lo(w.z), bf_hi(w.z), bf_lo(w.w), bf_hi(w.w)}; }
constexpr float EPSN = 1e-6f;
__device__ __forceinline__ void st_nt16(bf16_t* p, u32x4 v) { __builtin_nontemporal_store(v, (u32x4*)p); }
struct EpiSwiGLU { static constexpr bool PERM = true, AFTER_DRAIN = false, HAS_MID = false;
    bf16_t* O; int ldo; const float* ss; float inv_dim;
    __device__ __forceinline__ void operator()(const f32x4 (&acc)[2][2][4][2], const Unit& u, int wr, int wc, int fr, int fq) const {
        const int col0 = u.pn * 128 + wc * 32 + 8 * fq;
        float rsv[2][4];
#pragma unroll
        for (int ai = 0; ai < 2; ++ai)
#pragma unroll
            for (int m = 0; m < 4; ++m) rsv[ai][m] = ss[u.pm * BM + ai * HALF + wr * 64 + m * 16 + fr];
#pragma unroll
        for (int ai = 0; ai < 2; ++ai)
#pragma unroll
            for (int m = 0; m < 4; ++m) asm volatile("" : "+v"(rsv[ai][m]));
#pragma unroll
        for (int ai = 0; ai < 2; ++ai)
#pragma unroll
            for (int m = 0; m < 4; ++m) { const int row = u.pm * BM + ai * HALF + wr * 64 + m * 16 + fr; const float rs = rsqrtf(rsv[ai][m] * inv_dim + EPSN);
                f32x4 o[2];
#pragma unroll
                for (int n = 0; n < 2; ++n) { const f32x4 g = acc[ai][0][m][n] * rs, up = acc[ai][1][m][n] * rs;
#pragma unroll
                    for (int e = 0; e < 4; ++e) o[n][e] = g[e] * sigm(g[e]) * up[e]; }
                st_nt16(O + (size_t)row * ldo + col0, pack8(o[0], o[1])); }
    }
};
template <bool BF> struct EpiResid { static constexpr bool PERM = true, AFTER_DRAIN = false, HAS_MID = false;
    const float* base; bf16_t* xb; float* ssn; float alpha;
    __device__ __forceinline__ void operator()(const f32x4 (&acc)[2][2][4][2], const Unit& u, int wr, int wc, int fr, int fq) const {
        const int col = u.pn * BM + wc * 64 + 8 * fq;
#pragma unroll
        for (int ai = 0; ai < 2; ++ai) { const int row0 = u.pm * BM + ai * HALF + wr * 64 + fr;
            f32x4 bv[4][2][2];
#pragma unroll
            for (int m = 0; m < 4; ++m)
#pragma unroll
                for (int bj = 0; bj < 2; ++bj) { const size_t off = (size_t)(row0 + m * 16) * 2048 + col + bj * 32;
                    if (BF) unpack8(*(const u32x4*)(xb + off), bv[m][bj][0], bv[m][bj][1]);
                    else { bv[m][bj][0] = *(const f32x4*)(base + off); bv[m][bj][1] = *(const f32x4*)(base + off + 4); } }
#pragma unroll
            for (int m = 0; m < 4; ++m) { const int row = row0 + m * 16; float s = 0.f;
#pragma unroll
                for (int bj = 0; bj < 2; ++bj) { const size_t off = (size_t)row * 2048 + col + bj * 32;
                    const f32x4 v0 = bv[m][bj][0] + acc[ai][bj][m][0] * alpha, v1 = bv[m][bj][1] + acc[ai][bj][m][1] * alpha;
                    *(u32x4*)(xb + off) = pack8(v0, v1);
                    s += (v0[0] * v0[0] + v0[1] * v0[1]) + (v0[2] * v0[2] + v0[3] * v0[3]) + (v1[0] * v1[0] + v1[1] * v1[1]) + (v1[2] * v1[2] + v1[3] * v1[3]); }
                s += __shfl_xor(s, 16); s += __shfl_xor(s, 32);
                if (fq == 0) atomicAdd(ssn + row, s); }
            asm volatile("" ::: "memory"); }
    }
};
template <int ACT> struct EpiScale { static constexpr bool PERM = true, AFTER_DRAIN = false, HAS_MID = false;
    bf16_t* O; int ldc; const float* ss; float inv_dim;
    __device__ __forceinline__ void operator()(const f32x4 (&acc)[2][2][4][2], const Unit& u, int wr, int wc, int fr, int fq) const {
        float rsv[2][4];
#pragma unroll
        for (int ai = 0; ai < 2; ++ai)
#pragma unroll
            for (int m = 0; m < 4; ++m) rsv[ai][m] = ss ? ss[u.pm * BM + ai * HALF + wr * 64 + m * 16 + fr] : 0.f;
#pragma unroll
        for (int ai = 0; ai < 2; ++ai)
#pragma unroll
            for (int m = 0; m < 4; ++m) asm volatile("" : "+v"(rsv[ai][m]));
#pragma unroll
        for (int ai = 0; ai < 2; ++ai)
#pragma unroll
            for (int m = 0; m < 4; ++m) { const int row = u.pm * BM + ai * HALF + wr * 64 + m * 16 + fr; const float rs = ss ? rsqrtf(rsv[ai][m] * inv_dim + EPSN) : 1.f;
#pragma unroll
                for (int bj = 0; bj < 2; ++bj) { f32x4 v0 = acc[ai][bj][m][0] * rs, v1 = acc[ai][bj][m][1] * rs;
                    if (ACT == 1) {
#pragma unroll
                        for (int e = 0; e < 4; ++e) { v0[e] = sigm(v0[e]); v1[e] = sigm(v1[e]); } }
                    st_nt16(O + (size_t)row * ldc + u.pn * BM + wc * 64 + bj * 32 + 8 * fq, pack8(v0, v1)); } }
    }
};
struct EpiP3b { static constexpr bool PERM = true, AFTER_DRAIN = false, HAS_MID = false;
    bf16_t* small; bf16_t* gates; const float* ss; float* ss_cq; float* ss_ckv;
    __device__ __forceinline__ void operator()(const f32x4 (&acc)[2][2][4][2], const Unit& u, int wr, int wc, int fr, int fq) const {
        const bool sm = u.pn < 4; bf16_t* O = sm ? small : gates; const int ldc = sm ? 1024 : 4096, colt = sm ? u.pn * BM : (u.pn - 4) * BM;
        float* ssq = (u.pn < 2) ? ss_cq : (u.pn == 2 ? ss_ckv : nullptr);
        float rsv[2][4];
#pragma unroll
        for (int ai = 0; ai < 2; ++ai)
#pragma unroll
            for (int m = 0; m < 4; ++m) rsv[ai][m] = ss[u.pm * BM + ai * HALF + wr * 64 + m * 16 + fr];
#pragma unroll
        for (int ai = 0; ai < 2; ++ai)
#pragma unroll
            for (int m = 0; m < 4; ++m) asm volatile("" : "+v"(rsv[ai][m]));
#pragma unroll
        for (int ai = 0; ai < 2; ++ai)
#pragma unroll
            for (int m = 0; m < 4; ++m) { const int row = u.pm * BM + ai * HALF + wr * 64 + m * 16 + fr; const float rs = rsqrtf(rsv[ai][m] * (1.f / 2048.f) + EPSN); float s = 0.f;
#pragma unroll
                for (int bj = 0; bj < 2; ++bj) { f32x4 v0 = acc[ai][bj][m][0] * rs, v1 = acc[ai][bj][m][1] * rs;
                    if (!sm) {
#pragma unroll
                        for (int e = 0; e < 4; ++e) { v0[e] = sigm(v0[e]); v1[e] = sigm(v1[e]); } }
                    s += (v0[0] * v0[0] + v0[1] * v0[1]) + (v0[2] * v0[2] + v0[3] * v0[3]) + (v1[0] * v1[0] + v1[1] * v1[1]) + (v1[2] * v1[2] + v1[3] * v1[3]);
                    st_nt16(O + (size_t)row * ldc + colt + wc * 64 + bj * 32 + 8 * fq, pack8(v0, v1)); }
                if (ssq) { s += __shfl_xor(s, 16); s += __shfl_xor(s, 32); if (fq == 0) atomicAdd(ssq + row, s); } }
    }
};
template <bool FIRST> struct EpiBr { static constexpr bool PERM = true, AFTER_DRAIN = false, HAS_MID = false;
    bf16_t* T; const bf16_t* gates;
    __device__ __forceinline__ void operator()(const f32x4 (&acc)[2][2][4][2], const Unit& u, int wr, int wc, int fr, int fq) const {
        const int col = u.pn * BM + wc * 64 + 8 * fq;
#pragma unroll
        for (int ai = 0; ai < 2; ++ai) { const int row0 = u.pm * BM + ai * HALF + wr * 64 + fr;
            u32x4 gv[4][2], tv[4][2];
#pragma unroll
            for (int m = 0; m < 4; ++m)
#pragma unroll
                for (int bj = 0; bj < 2; ++bj) { const int c = col + bj * 32; gv[m][bj] = *(const u32x4*)(gates + (size_t)(row0 + m * 16) * 4096 + (FIRST ? 0 : 2048) + c);
                    if (!FIRST) tv[m][bj] = *(const u32x4*)(T + (size_t)(row0 + m * 16) * 2048 + c); }
#pragma unroll
            for (int m = 0; m < 4; ++m)
#pragma unroll
                for (int bj = 0; bj < 2; ++bj) { f32x4 g0, g1; unpack8(gv[m][bj], g0, g1);
                    f32x4 v0 = acc[ai][bj][m][0] * g0, v1 = acc[ai][bj][m][1] * g1;
                    if (!FIRST) { f32x4 t0, t1; unpack8(tv[m][bj], t0, t1); v0 += t0; v1 += t1; }
                    *(u32x4*)(T + (size_t)(row0 + m * 16) * 2048 + col + bj * 32) = pack8(v0, v1); }
            asm volatile("" ::: "memory"); }
    }
};
struct EpiBrChain { static constexpr bool PERM = true, AFTER_DRAIN = false, HAS_MID = true;
    bf16_t* T; const bf16_t* gates;
    __device__ __forceinline__ void mid(f32x4 (&acc)[2][2][4][2], const Unit& u, int wr, int wc, int fr, int fq) const {
        const int col = u.pn * BM + wc * 64 + 8 * fq;
#pragma unroll
        for (int ai = 0; ai < 2; ++ai)
#pragma unroll
            for (int mp = 0; mp < 2; ++mp) { const int row0 = u.pm * BM + ai * HALF + wr * 64 + mp * 32 + fr;
                u32x4 ga[2][2], gb[2][2];
#pragma unroll
                for (int mm = 0; mm < 2; ++mm)
#pragma unroll
                    for (int bj = 0; bj < 2; ++bj) { const bf16_t* gp = gates + (size_t)(row0 + mm * 16) * 4096 + col + bj * 32; ga[mm][bj] = *(const u32x4*)gp; gb[mm][bj] = *(const u32x4*)(gp + 2048); }
#pragma unroll
                for (int mm = 0; mm < 2; ++mm)
#pragma unroll
                    for (int bj = 0; bj < 2; ++bj) { f32x4 a0, a1, b0, b1; unpack8(ga[mm][bj], a0, a1); unpack8(gb[mm][bj], b0, b1); const int m = mp * 2 + mm;
#pragma unroll
                        for (int e = 0; e < 4; ++e) { acc[ai][bj][m][0][e] *= a0[e] * __builtin_amdgcn_rcpf(fmaxf(b0[e], 1e-30f)); acc[ai][bj][m][1][e] *= a1[e] * __builtin_amdgcn_rcpf(fmaxf(b1[e], 1e-30f)); } }
                asm volatile("" ::: "memory"); }
    }
    __device__ __forceinline__ void operator()(const f32x4 (&acc)[2][2][4][2], const Unit& u, int wr, int wc, int fr, int fq) const {
        const int col = u.pn * BM + wc * 64 + 8 * fq;
#pragma unroll
        for (int ai = 0; ai < 2; ++ai) { const int row0 = u.pm * BM + ai * HALF + wr * 64 + fr;
            u32x4 gb[4][2];
#pragma unroll
            for (int m = 0; m < 4; ++m)
#pragma unroll
                for (int bj = 0; bj < 2; ++bj) gb[m][bj] = *(const u32x4*)(gates + (size_t)(row0 + m * 16) * 4096 + 2048 + col + bj * 32);
#pragma unroll
            for (int m = 0; m < 4; ++m)
#pragma unroll
                for (int bj = 0; bj < 2; ++bj) { f32x4 b0, b1; unpack8(gb[m][bj], b0, b1);
                    *(u32x4*)(T + (size_t)(row0 + m * 16) * 2048 + col + bj * 32) = pack8(acc[ai][bj][m][0] * b0, acc[ai][bj][m][1] * b1); }
            asm volatile("" ::: "memory"); }
    }
};
struct EpiPle { static constexpr bool PERM = true, AFTER_DRAIN = false, HAS_MID = false;
    float* out; const bf16_t* xb; const bf16_t* T; const float* ss;
    __device__ __forceinline__ void operator()(const f32x4 (&acc)[2][2][4][2], const Unit& u, int wr, int wc, int fr, int fq) const {
        const int col = u.pn * BM + wc * 64 + 8 * fq;
        float rsv[2][4];
#pragma unroll
        for (int ai = 0; ai < 2; ++ai)
#pragma unroll
            for (int m = 0; m < 4; ++m) rsv[ai][m] = ss[u.pm * BM + ai * HALF + wr * 64 + m * 16 + fr];
#pragma unroll
        for (int ai = 0; ai < 2; ++ai) { const int row0 = u.pm * BM + ai * HALF + wr * 64 + fr;
            u32x4 tv[4][2], xv[4][2];
#pragma unroll
            for (int m = 0; m < 4; ++m)
#pragma unroll
                for (int bj = 0; bj < 2; ++bj) { const size_t off = (size_t)(row0 + m * 16) * 2048 + col + bj * 32; tv[m][bj] = *(const u32x4*)(T + off); xv[m][bj] = *(const u32x4*)(xb + off); }
#pragma unroll
            for (int m = 0; m < 4; ++m) { const float rs = rsqrtf(rsv[ai][m] * (1.f / 2048.f) + EPSN);
#pragma unroll
                for (int bj = 0; bj < 2; ++bj) { const size_t off = (size_t)(row0 + m * 16) * 2048 + col + bj * 32;
                    f32x4 t0, t1, v0, v1; unpack8(tv[m][bj], t0, t1); unpack8(xv[m][bj], v0, v1);
#pragma unroll
                    for (int e = 0; e < 4; ++e) { v0[e] += sigm(acc[ai][bj][m][0][e] * rs) * t0[e]; v1[e] += sigm(acc[ai][bj][m][1][e] * rs) * t1[e]; }
                    __builtin_nontemporal_store(v0, (f32x4*)(out + off)); __builtin_nontemporal_store(v1, (f32x4*)(out + off + 4)); } }
            asm volatile("" ::: "memory"); }
    }
};
template <class Epi, class Sched, bool ALIGN_EPI = false, bool SP2 = false>
__device__ __forceinline__ void gemm_phase(PG8_LAS unsigned char* lds, const Gemm g, const Sched& S, const Epi& E) {
    const int tid = threadIdx.x, wid = __builtin_amdgcn_readfirstlane(tid >> 6), lane = tid & 63, wr = wid >> 2, wc = wid & 3, fr = lane & 15, fq = lane >> 4;
    int K = g.K; asm volatile("" : "+s"(K)); const int nt = K / BK;
    unsigned voffA[2], voffB[2];
#pragma unroll
    for (int i = 0; i < 2; ++i) { int R, C; stage_rc(tid * 16 + i * 8192, R, C); const int Rb = Epi::PERM ? ((R >> 5) * 64 + perm32(R & 31)) : R;
        voffA[i] = (unsigned)(R * g.lda + C) * 2u; voffB[i] = (unsigned)(Rb * g.ldb + C) * 2u; }
    const size_t kstep = (size_t)(BK * 2);
    const size_t hstepA = (size_t)HALF * g.lda * 2, hstepB = (size_t)(Epi::PERM ? 32 : HALF) * g.ldb * 2;
    const size_t tstepA = 2 * hstepA, tstepB = (size_t)BM * g.ldb * 2;
    const unsigned ldsw = (unsigned)wid * 1024u;
    const int aoff = lds_byte(wr * 64 + fr, fq * 8), boff = lds_byte(wc * 32 + fr, fq * 8);
#define PG8_SA(b, h) (((b) * 2 + (h)) * HTB)
#define PG8_SB(b, h) ((4 + (b) * 2 + (h)) * HTB)
#define PG8_STAGE(bufoff, gbase, voff) do { _Pragma("unroll") for (int _i = 0; _i < 2; ++_i) \
        __builtin_amdgcn_global_load_lds((const unsigned*)((const char*)(gbase) + (voff)[_i]), (PG8_LAS unsigned*)(lds + (bufoff) + ldsw + _i * 8192), 16, 0, 0); } while (0)
#define PG8_LDA(dst, b, h) do { _Pragma("unroll") for (int m = 0; m < 4; ++m) _Pragma("unroll") for (int k = 0; k < 2; ++k) dst[m][k] = *(const PG8_LAS bf16x8*)(lds + PG8_SA(b, h) + aoff + m * 2048 + k * 1024); } while (0)
#define PG8_LDB(dst, b, h) do { _Pragma("unroll") for (int n = 0; n < 2; ++n) _Pragma("unroll") for (int k = 0; k < 2; ++k) dst[n][k] = *(const PG8_LAS bf16x8*)(lds + PG8_SB(b, h) + boff + n * 2048 + k * 1024); } while (0)
#define PG8_MMA(ai, bj, At, Bt) do { __builtin_amdgcn_s_setprio(1); _Pragma("unroll") for (int m = 0; m < 4; ++m) _Pragma("unroll") for (int n = 0; n < 2; ++n) _Pragma("unroll") for (int k = 0; k < 2; ++k) \
        acc[ai][bj][m][n] = __builtin_amdgcn_mfma_f32_16x16x32_bf16(Bt[n][k], At[m][k], acc[ai][bj][m][n], 0, 0, 0); __builtin_amdgcn_s_setprio(0); } while (0)
#define PG8_WAIT_V(n) asm volatile("s_waitcnt vmcnt(" #n ")" ::: "memory")
#define PG8_WAIT_L(n) asm volatile("s_waitcnt lgkmcnt(" #n ")" ::: "memory")
#define PG8_BAR __builtin_amdgcn_s_barrier()
#define PG8_SCHED __builtin_amdgcn_sched_barrier(0)
    Unit cur, nxt; int ui = 0;
    if (!S.next(0, cur)) return;
    f32x4 acc[2][2][4][2];
#pragma unroll
    for (int a = 0; a < 2; ++a)
#pragma unroll
        for (int b = 0; b < 2; ++b)
#pragma unroll
            for (int m = 0; m < 4; ++m)
#pragma unroll
                for (int n = 0; n < 2; ++n) acc[a][b][m][n] = (f32x4){0.f, 0.f, 0.f, 0.f};
    bf16x8 At[4][2], B0[2][2], B1[2][2];
    const char* cA = (const char*)(Sched::CHAIN && cur.part == 5 ? g.A2 : g.A) + (size_t)cur.pm * tstepA + (size_t)cur.k0 * kstep; const char* cB = (const char*)(Sched::CHAIN && cur.part == 5 ? g.Bt2 : g.Bt) + (size_t)cur.pn * tstepB + (size_t)cur.k0 * kstep;
    S.a_ready(cur);
    if constexpr (SP2) {
        PG8_STAGE(PG8_SB(0, 0), cB, voffB); PG8_STAGE(PG8_SB(0, 1), cB + hstepB, voffB); PG8_STAGE(PG8_SA(0, 0), cA, voffA); PG8_STAGE(PG8_SA(0, 1), cA + hstepA, voffA);
        if (wr == 1) PG8_BAR;
        PG8_WAIT_V(2); PG8_BAR;
        PG8_STAGE(PG8_SB(1, 0), cB + kstep, voffB); PG8_STAGE(PG8_SA(1, 0), cA + kstep, voffA); PG8_STAGE(PG8_SB(1, 1), cB + hstepB + kstep, voffB);
        PG8_WAIT_V(6); PG8_BAR;
    } else {
        PG8_STAGE(PG8_SB(0, 0), cB, voffB); PG8_STAGE(PG8_SA(0, 0), cA, voffA); PG8_STAGE(PG8_SB(0, 1), cB + hstepB, voffB); PG8_STAGE(PG8_SA(0, 1), cA + hstepA, voffA);
        if (wr == 1) PG8_BAR;
        PG8_WAIT_V(4); PG8_BAR;
        PG8_STAGE(PG8_SB(1, 0), cB + kstep, voffB); PG8_STAGE(PG8_SA(1, 0), cA + kstep, voffA); PG8_STAGE(PG8_SB(1, 1), cB + hstepB + kstep, voffB);
        PG8_WAIT_V(6); PG8_BAR;
    }
    for (;;) {
        const bool has_next = S.next(ui + 1, nxt);
        const char* nA = has_next ? (const char*)(Sched::CHAIN && nxt.part == 5 ? g.A2 : g.A) + (size_t)nxt.pm * tstepA + (size_t)nxt.k0 * kstep : cA; const char* nB = has_next ? (const char*)(Sched::CHAIN && nxt.part == 5 ? g.Bt2 : g.Bt) + (size_t)nxt.pn * tstepB + (size_t)nxt.k0 * kstep : cB;
        int ntu = cur.nk; asm volatile("" : "+v"(ntu)); ntu = __builtin_amdgcn_readfirstlane(ntu);
        for (int t = 0; t < ntu; t += 2) {
            const bool last = (t == ntu - 2);
            const char* a1 = cA + (size_t)(t + 1) * kstep;
            const char* a2 = last ? nA : cA + (size_t)(t + 2) * kstep; const char* b2 = last ? nB : cB + (size_t)(t + 2) * kstep;
            const char* a3 = a2 + kstep; const char* b3 = b2 + kstep;
            if (last && has_next) S.a_ready(nxt);
            if constexpr (SP2) {
            PG8_LDB(B0, 0, 0); PG8_LDB(B1, 0, 1); PG8_SCHED; PG8_LDA(At, 0, 0); PG8_STAGE(PG8_SA(1, 1), a1 + hstepA, voffA);
            PG8_WAIT_V(8); PG8_WAIT_L(0); PG8_BAR; PG8_MMA(0, 0, At, B0); PG8_MMA(0, 1, At, B1); PG8_BAR; PG8_SCHED;
            PG8_LDA(At, 0, 1); PG8_STAGE(PG8_SB(0, 0), b2, voffB); PG8_STAGE(PG8_SB(0, 1), b2 + hstepB, voffB); PG8_STAGE(PG8_SA(0, 0), a2, voffA);
            PG8_WAIT_V(8); PG8_WAIT_L(0); PG8_BAR; PG8_MMA(1, 0, At, B0); PG8_MMA(1, 1, At, B1); PG8_BAR; PG8_SCHED;
            PG8_LDB(B0, 1, 0); PG8_LDB(B1, 1, 1); PG8_SCHED; PG8_LDA(At, 1, 0); PG8_STAGE(PG8_SA(0, 1), a2 + hstepA, voffA);
            PG8_WAIT_V(8); PG8_WAIT_L(0); PG8_BAR; PG8_MMA(0, 0, At, B0); PG8_MMA(0, 1, At, B1); PG8_BAR; PG8_SCHED;
            PG8_LDA(At, 1, 1); PG8_STAGE(PG8_SB(1, 0), b3, voffB); PG8_STAGE(PG8_SB(1, 1), b3 + hstepB, voffB); PG8_STAGE(PG8_SA(1, 0), a3, voffA);
            PG8_WAIT_V(8); PG8_WAIT_L(0); PG8_BAR; PG8_MMA(1, 0, At, B0); PG8_MMA(1, 1, At, B1); PG8_BAR; PG8_SCHED;
            } else {
            PG8_LDB(B0, 0, 0); PG8_SCHED; PG8_LDA(At, 0, 0); PG8_STAGE(PG8_SA(1, 1), a1 + hstepA, voffA);
            PG8_WAIT_L(8); PG8_BAR; PG8_WAIT_L(0); PG8_MMA(0, 0, At, B0); PG8_BAR; PG8_SCHED;
            PG8_LDB(B1, 0, 1); PG8_STAGE(PG8_SB(0, 0), b2, voffB);
            PG8_BAR; PG8_WAIT_L(0); PG8_MMA(0, 1, At, B1); PG8_BAR;
            PG8_LDA(At, 0, 1); PG8_STAGE(PG8_SA(0, 0), a2, voffA);
            PG8_BAR; PG8_WAIT_L(0); PG8_MMA(1, 0, At, B0); PG8_BAR; PG8_SCHED;
            PG8_STAGE(PG8_SB(0, 1), b2 + hstepB, voffB);
            PG8_WAIT_V(6); PG8_BAR; PG8_MMA(1, 1, At, B1); PG8_BAR;
            PG8_LDB(B0, 1, 0); PG8_SCHED; PG8_LDA(At, 1, 0); PG8_STAGE(PG8_SA(0, 1), a2 + hstepA, voffA);
            PG8_WAIT_L(8); PG8_BAR; PG8_WAIT_L(0); PG8_MMA(0, 0, At, B0); PG8_BAR; PG8_SCHED;
            PG8_LDB(B1, 1, 1); PG8_STAGE(PG8_SB(1, 0), b3, voffB);
            PG8_BAR; PG8_WAIT_L(0); PG8_MMA(0, 1, At, B1); PG8_BAR;
            PG8_LDA(At, 1, 1); PG8_STAGE(PG8_SA(1, 0), a3, voffA);
            PG8_BAR; PG8_WAIT_L(0); PG8_MMA(1, 0, At, B0); PG8_BAR; PG8_SCHED;
            PG8_STAGE(PG8_SB(1, 1), b3 + hstepB, voffB);
            PG8_WAIT_V(6); PG8_BAR; PG8_MMA(1, 1, At, B1); PG8_BAR;
            }
        }
        if constexpr (ALIGN_EPI) { if (wr == 0) PG8_BAR; }
        if constexpr (!Epi::AFTER_DRAIN) {
            if (Sched::SPLIT && cur.part == 1) {
                f32x4* sp = (f32x4*)S.scratch + (size_t)blockIdx.x * (32 * BM * 2) + tid;
#pragma unroll
                for (int a = 0; a < 2; ++a)
#pragma unroll
                    for (int b = 0; b < 2; ++b)
#pragma unroll
                        for (int m = 0; m < 4; ++m)
#pragma unroll
                            for (int n = 0; n < 2; ++n) { *sp = acc[a][b][m][n]; sp += BM * 2; asm volatile("" : "+v"(sp)); }
            } else if (Sched::CHAIN && cur.part == 4) { if constexpr (Epi::HAS_MID) E.mid(acc, cur, wr, wc, fr, fq); }
            else { E(acc, cur, wr, wc, fr, fq); }
            S.done(cur); }
        if (!has_next) break;
        if (!(Sched::CHAIN && cur.part == 4))
#pragma unroll
        for (int a = 0; a < 2; ++a)
#pragma unroll
            for (int b = 0; b < 2; ++b)
#pragma unroll
                for (int m = 0; m < 4; ++m)
#pragma unroll
                    for (int n = 0; n < 2; ++n) acc[a][b][m][n] = (f32x4){0.f, 0.f, 0.f, 0.f};
        if (Sched::SPLIT && nxt.part == 2) {
            const f32x4* sp = (const f32x4*)S.scratch + (size_t)blockIdx.x * (32 * BM * 2) + tid;
#pragma unroll
            for (int a = 0; a < 2; ++a)
#pragma unroll
                for (int b = 0; b < 2; ++b)
#pragma unroll
                    for (int m = 0; m < 4; ++m)
#pragma unroll
                        for (int n = 0; n < 2; ++n) { acc[a][b][m][n] = *sp; sp += BM * 2; asm volatile("" : "+v"(sp)); }
        }
        cur = nxt; cA = nA; cB = nB; ++ui;
        if constexpr (ALIGN_EPI) { if (wr == 1) PG8_BAR; }
    }
    PG8_WAIT_V(0);
    if constexpr (!ALIGN_EPI) { if (wr == 0) PG8_BAR; }
    PG8_BAR;
    if constexpr (Epi::AFTER_DRAIN) { E.fused(acc, cur, wr, wc, fr, fq, lds, wid, lane); S.done(cur); }
#undef PG8_SA
#undef PG8_SB
#undef PG8_STAGE
#undef PG8_LDA
#undef PG8_LDB
#undef PG8_MMA
#undef PG8_WAIT_V
#undef PG8_WAIT_L
#undef PG8_BAR
#undef PG8_SCHED
}
}

namespace att {
typedef unsigned short bf16_t;
typedef short bf16x8 __attribute__((ext_vector_type(8)));
typedef short s16x4 __attribute__((ext_vector_type(4)));
typedef float f32x16 __attribute__((ext_vector_type(16)));
typedef unsigned u32x4 __attribute__((ext_vector_type(4)));
typedef float f32x4v __attribute__((ext_vector_type(4)));
constexpr int NW = 8, QBLK = 32, KVBLK = 64, QB = 256, SHM_V = 16384;
constexpr float THR = 8.f;
#define ALAS __attribute__((address_space(3)))
#define SBAR() __builtin_amdgcn_sched_barrier(0)
__device__ __forceinline__ int v_st(int k, int c) { const int kk = (k & ~0xC) | ((k & 4) << 1) | ((k & 8) >> 1); return ((kk >> 3) * 4 + (c >> 5)) * 512 + ((kk & 7) * 32 + (c & 31)) * 2; }
__device__ __forceinline__ int v_rd_base(int lane) { return ((lane & 3) << 3) | (((lane >> 2) & 3) << 6) | (((lane >> 4) & 1) << 5) | (((lane >> 5) & 1) << 8); }
constexpr int v_rd_off(int d0, int ks, int half) { return d0 * 512 + ks * 4096 + half * 2048; }
__device__ __forceinline__ int crow(int r, int hi) { return (r & 3) + 8 * (r >> 2) + 4 * hi; }
__device__ __forceinline__ unsigned cvtpk(float lo, float hi) { unsigned r; asm volatile("v_cvt_pk_bf16_f32 %0, %1, %2" : "=v"(r) : "v"(lo), "v"(hi)); return r; }
__device__ __forceinline__ void glds16(const void* gsrc, unsigned lds_dst) { unsigned keep;
    asm volatile("s_mov_b32 %0, m0\n\ts_mov_b32 m0, %2\n\ts_nop 0\n\tglobal_load_lds_dwordx4 %1, off\n\ts_mov_b32 m0, %0" : "=&s"(keep) : "v"(gsrc), "s"(lds_dst) : "memory"); }
__device__ __forceinline__ void mask_tile(f32x16& p0, f32x16& p1, int dq, unsigned W) {
    const float NEG = -__builtin_inff();
#pragma unroll
    for (int r = 0; r < 16; ++r) { const int c = (r & 3) + 8 * (r >> 2);
        if ((unsigned)(dq - c) >= W) p0[r] = NEG;
        if ((unsigned)(dq - c - 32) >= W) p1[r] = NEG; }
}
__device__ __forceinline__ void softmax_p1(f32x16& p0, f32x16& p1, float& m_reg, float& alpha) {
    float pa = fmaxf(p0[0], p0[1]), pb = fmaxf(p0[2], p0[3]), pc = fmaxf(p1[0], p1[1]), pd = fmaxf(p1[2], p1[3]);
#pragma unroll
    for (int r = 4; r < 16; r += 4) { pa = fmaxf(pa, fmaxf(p0[r], p0[r + 1])); pb = fmaxf(pb, fmaxf(p0[r + 2], p0[r + 3])); pc = fmaxf(pc, fmaxf(p1[r], p1[r + 1])); pd = fmaxf(pd, fmaxf(p1[r + 2], p1[r + 3])); }
    float pmax = fmaxf(fmaxf(pa, pb), fmaxf(pc, pd));
    { auto rr = __builtin_amdgcn_permlane32_swap(__float_as_uint(pmax), __float_as_uint(pmax), false, false); pmax = fmaxf(__uint_as_float(rr[0]), __uint_as_float(rr[1])); }
    float mn;
    if (__builtin_expect(__all((pmax - m_reg) <= THR), 1)) { mn = m_reg; alpha = 1.f; }
    else { mn = fmaxf(m_reg, pmax); alpha = __builtin_amdgcn_exp2f(m_reg - mn); m_reg = mn; }
#pragma unroll
    for (int r = 0; r < 16; ++r) { p0[r] = __builtin_amdgcn_exp2f(p0[r] - mn); p1[r] = __builtin_amdgcn_exp2f(p1[r] - mn); }
}
__device__ __forceinline__ void softmax_p2(f32x16& p0, f32x16& p1, float alpha, float& l_reg, bf16x8& pa0, bf16x8& pa1, bf16x8& pa2, bf16x8& pa3) {
    float sa = 0.f, sb = 0.f, sc = 0.f, sd = 0.f;
#pragma unroll
    for (int r = 0; r < 16; r += 2) { sa += p0[r]; sb += p0[r + 1]; sc += p1[r]; sd += p1[r + 1]; }
    float ps = (sa + sb) + (sc + sd);
    { auto rr = __builtin_amdgcn_permlane32_swap(__float_as_uint(ps), __float_as_uint(ps), false, false); ps = __uint_as_float(rr[0]) + __uint_as_float(rr[1]); }
    l_reg = l_reg * alpha + ps;
#define PK4(P, B_, OUT) do { unsigned a0 = cvtpk(P[B_+0], P[B_+1]), a1 = cvtpk(P[B_+2], P[B_+3]); unsigned b0 = cvtpk(P[B_+4], P[B_+5]), b1 = cvtpk(P[B_+6], P[B_+7]); \
        auto r0 = __builtin_amdgcn_permlane32_swap(a0, b0, false, false); auto r1 = __builtin_amdgcn_permlane32_swap(a1, b1, false, false); \
        u32x4 w = {r0[0], r1[0], r0[1], r1[1]}; OUT = *reinterpret_cast<bf16x8*>(&w); } while (0)
    PK4(p0, 0, pa0); PK4(p0, 8, pa1); PK4(p1, 0, pa2); PK4(p1, 8, pa3);
#undef PK4
}
template <bool PF> __device__ __forceinline__ void pv_tile(f32x16* o, int vb0, bf16x8 pa0, bf16x8 pa1, bf16x8 pa2, bf16x8 pa3) {
#define TRRD(dst, off) asm volatile("ds_read_b64_tr_b16 %0, %1 offset:%2" : "=&v"(dst) : "v"(vb0), "i"(off) : "memory")
#define RD8(L, d0) do { constexpr int b_ = v_rd_off(d0, 0, 0); TRRD(L[0], b_); TRRD(L[1], b_ + 2048); TRRD(L[2], b_ + 4096); TRRD(L[3], b_ + 6144); TRRD(L[4], b_ + 8192); TRRD(L[5], b_ + 10240); TRRD(L[6], b_ + 12288); TRRD(L[7], b_ + 14336); } while (0)
#define MM4(L, d0) do { \
        o[d0] = __builtin_amdgcn_mfma_f32_32x32x16_bf16((bf16x8){L[0][0], L[0][1], L[0][2], L[0][3], L[1][0], L[1][1], L[1][2], L[1][3]}, pa0, o[d0], 0, 0, 0); \
        o[d0] = __builtin_amdgcn_mfma_f32_32x32x16_bf16((bf16x8){L[2][0], L[2][1], L[2][2], L[2][3], L[3][0], L[3][1], L[3][2], L[3][3]}, pa1, o[d0], 0, 0, 0); \
        o[d0] = __builtin_amdgcn_mfma_f32_32x32x16_bf16((bf16x8){L[4][0], L[4][1], L[4][2], L[4][3], L[5][0], L[5][1], L[5][2], L[5][3]}, pa2, o[d0], 0, 0, 0); \
        o[d0] = __builtin_amdgcn_mfma_f32_32x32x16_bf16((bf16x8){L[6][0], L[6][1], L[6][2], L[6][3], L[7][0], L[7][1], L[7][2], L[7][3]}, pa3, o[d0], 0, 0, 0); } while (0)
    if constexpr (PF) {
    s16x4 A[8], B[8];
    RD8(A, 0); RD8(B, 1);
    asm volatile("s_waitcnt lgkmcnt(8)" ::: "memory"); SBAR(); MM4(A, 0); SBAR();
    RD8(A, 2);
    asm volatile("s_waitcnt lgkmcnt(8)" ::: "memory"); SBAR(); MM4(B, 1); SBAR();
    RD8(B, 3);
    asm volatile("s_waitcnt lgkmcnt(8)" ::: "memory"); SBAR(); MM4(A, 2); SBAR();
    asm volatile("s_waitcnt lgkmcnt(0)" ::: "memory"); SBAR(); MM4(B, 3);
    } else {
    s16x4 A[8];
    RD8(A, 0); asm volatile("s_waitcnt lgkmcnt(0)" ::: "memory"); SBAR(); MM4(A, 0); SBAR();
    RD8(A, 1); asm volatile("s_waitcnt lgkmcnt(0)" ::: "memory"); SBAR(); MM4(A, 1); SBAR();
    RD8(A, 2); asm volatile("s_waitcnt lgkmcnt(0)" ::: "memory"); SBAR(); MM4(A, 2); SBAR();
    RD8(A, 3); asm volatile("s_waitcnt lgkmcnt(0)" ::: "memory"); SBAR(); MM4(A, 3);
    }
#undef MM4
#undef RD8
#undef TRRD
}
template <int ND, int KROW> __device__ __forceinline__ void qk_tile(f32x16& p0, f32x16& p1, const ALAS char* Kb, const int (&kb4)[4], const bf16x8* qr) {
    bf16x8 R[3][2];
#define LDK(slot, d0) do { const ALAS char* ka = Kb + kb4[(d0) & 3] + ((d0) >> 2) * 128; R[slot][0] = *(const ALAS bf16x8*)(ka); R[slot][1] = *(const ALAS bf16x8*)(ka + 32 * KROW); } while (0)
    LDK(0, 0); LDK(1, 1); LDK(2, 2);
    p0 = f32x16{}; p1 = f32x16{};
#pragma unroll
    for (int d0 = 0; d0 < ND; ++d0) {
        SBAR();
        p0 = __builtin_amdgcn_mfma_f32_32x32x16_bf16(R[d0 % 3][0], qr[d0], p0, 0, 0, 0); p1 = __builtin_amdgcn_mfma_f32_32x32x16_bf16(R[d0 % 3][1], qr[d0], p1, 0, 0, 0);
        SBAR();
        if (d0 + 3 < ND) LDK(d0 % 3, d0 + 3);
    }
#undef LDK
}
struct Blk { const bf16_t* Q; const bf16_t* K; const bf16_t* V; bf16_t* O; long ldq, ldk, ldv, ldo; int P0, skv, W; float* mo; float* lo; long ldml;
             const float* qgain; const int* qpos; int qpstride; const float* qtab; };
template <int DQK>
__device__ __forceinline__ void attn_block(const Blk& b, ALAS unsigned char* ldsp) {
    char* lds = (char*)ldsp;
    constexpr bool WSK = (DQK == 128);
    constexpr int ND = DQK / 16, KROW = DQK * 2, SHM_K = 64 * KROW, CPR = DQK / 8, NKC = (64 * CPR) / 512;
    const int tid = threadIdx.x, wid = __builtin_amdgcn_readfirstlane(tid >> 6), lane = tid & 63, r32 = lane & 31, hi = lane >> 5;
    char* V_lds = lds; char* K_lds = lds + 3 * SHM_V; float* ws = (float*)(lds + 3 * SHM_V + 3 * SHM_K) + wid * 64;
    const int lowk = b.P0 - b.W + 1; const int j_lo = lowk > 0 ? lowk / KVBLK : 0;
    int j_hi = (b.P0 + QB - 1) / KVBLK + 1; if (j_hi > b.skv / KVBLK) j_hi = b.skv / KVBLK;
    const int NT = j_hi - j_lo;
    const int qlo = b.P0 + wid * QBLK, qm = qlo + r32 - 4 * hi;
    bf16x8 qr[ND];
#pragma unroll
    for (int d0 = 0; d0 < ND; ++d0) qr[d0] = *(const bf16x8*)(b.Q + (size_t)(wid * QBLK + r32) * b.ldq + d0 * 16 + hi * 8);
    if constexpr (DQK == 128) { if (b.qgain) {
        float qf[8][8]; float ssq = 0.f;
#pragma unroll
        for (int d0 = 0; d0 < 8; ++d0) { const u32x4 w = __builtin_bit_cast(u32x4, qr[d0]);
            qf[d0][0] = __uint_as_float(w.x << 16); qf[d0][1] = __uint_as_float(w.x & 0xffff0000u); qf[d0][2] = __uint_as_float(w.y << 16); qf[d0][3] = __uint_as_float(w.y & 0xffff0000u);
            qf[d0][4] = __uint_as_float(w.z << 16); qf[d0][5] = __uint_as_float(w.z & 0xffff0000u); qf[d0][6] = __uint_as_float(w.w << 16); qf[d0][7] = __uint_as_float(w.w & 0xffff0000u);
#pragma unroll
            for (int e = 0; e < 8; ++e) ssq += qf[d0][e] * qf[d0][e]; }
        { auto rr = __builtin_amdgcn_permlane32_swap(__float_as_uint(ssq), __float_as_uint(ssq), false, false); ssq = __uint_as_float(rr[0]) + __uint_as_float(rr[1]); }
        const float rn = rsqrtf(ssq * (1.f / 128.f) + 1e-6f) * (0.08838834764831845f * 1.4426950408889634f);
        const float pos = (float)b.qpos[(size_t)(wid * QBLK + r32) * b.qpstride];
#pragma unroll
        for (int d0 = 0; d0 < 8; ++d0) { const f32x4v ga = *(const f32x4v*)(b.qgain + d0 * 16 + hi * 8), gb = *(const f32x4v*)(b.qgain + d0 * 16 + hi * 8 + 4);
#pragma unroll
            for (int e = 0; e < 8; ++e) qf[d0][e] *= rn * (e < 4 ? ga[e] : gb[e - 4]); }
#pragma unroll
        for (int e = 0; e < 8; ++e) { const int jj = 8 * hi + e; const float inv = exp2f(-(float)jj * (1.f / 16.f) * 18.931568569324174f);
            double rv = (double)(pos * inv) * 0.15915494309189535; rv -= __builtin_rint(rv); const float fr_ = (float)rv; const float sn = __builtin_amdgcn_sinf(fr_), cs = __builtin_amdgcn_cosf(fr_);
            const float x1 = qf[0][e], x2 = qf[1][e]; qf[0][e] = x1 * cs - x2 * sn; qf[1][e] = x2 * cs + x1 * sn; }
#pragma unroll
        for (int d0 = 0; d0 < 8; ++d0) { u32x4 w = {cvtpk(qf[d0][0], qf[d0][1]), cvtpk(qf[d0][2], qf[d0][3]), cvtpk(qf[d0][4], qf[d0][5]), cvtpk(qf[d0][6], qf[d0][7])}; qr[d0] = __builtin_bit_cast(bf16x8, w); }
    } }
    if constexpr (DQK == 192) { if (b.qgain) {
#define UNPK(W, F) do { F[0] = __uint_as_float(W.x << 16); F[1] = __uint_as_float(W.x & 0xffff0000u); F[2] = __uint_as_float(W.y << 16); F[3] = __uint_as_float(W.y & 0xffff0000u); \
        F[4] = __uint_as_float(W.z << 16); F[5] = __uint_as_float(W.z & 0xffff0000u); F[6] = __uint_as_float(W.w << 16); F[7] = __uint_as_float(W.w & 0xffff0000u); } while (0)
        float ssq = 0.f;
#pragma unroll
        for (int d0 = 0; d0 < 12; ++d0) { const u32x4 w = __builtin_bit_cast(u32x4, qr[d0]); float f[8]; UNPK(w, f);
#pragma unroll
            for (int e = 0; e < 8; ++e) ssq += f[e] * f[e]; }
        { auto rr = __builtin_amdgcn_permlane32_swap(__float_as_uint(ssq), __float_as_uint(ssq), false, false); ssq = __uint_as_float(rr[0]) + __uint_as_float(rr[1]); }
        const float rn = rsqrtf(ssq * (1.f / 192.f) + 1e-6f) * (0.07216878364870323f * 1.4426950408889634f);
#pragma unroll
        for (int d0 = 0; d0 < 8; ++d0) { const u32x4 w = __builtin_bit_cast(u32x4, qr[d0]); float f[8]; UNPK(w, f);
            const f32x4v ga = *(const f32x4v*)(b.qgain + d0 * 16 + hi * 8), gb = *(const f32x4v*)(b.qgain + d0 * 16 + hi * 8 + 4);
#pragma unroll
            for (int e = 0; e < 8; ++e) f[e] *= rn * (e < 4 ? ga[e] : gb[e - 4]);
            u32x4 o_ = {cvtpk(f[0], f[1]), cvtpk(f[2], f[3]), cvtpk(f[4], f[5]), cvtpk(f[6], f[7])}; qr[d0] = __builtin_bit_cast(bf16x8, o_); asm volatile("" : "+v"(qr[d0])); }
#pragma unroll
        for (int t = 0; t < 2; ++t) { const u32x4 w1 = __builtin_bit_cast(u32x4, qr[8 + t]), w2 = __builtin_bit_cast(u32x4, qr[10 + t]); float f1[8], f2[8]; UNPK(w1, f1); UNPK(w2, f2);
            const f32x4v g1a = *(const f32x4v*)(b.qgain + (8 + t) * 16 + hi * 8), g1b = *(const f32x4v*)(b.qgain + (8 + t) * 16 + hi * 8 + 4);
            const f32x4v g2a = *(const f32x4v*)(b.qgain + (10 + t) * 16 + hi * 8), g2b = *(const f32x4v*)(b.qgain + (10 + t) * 16 + hi * 8 + 4);
            const float* tb = b.qtab + (size_t)(wid * QBLK + r32) * 64 + 16 * t + 8 * hi;
            const f32x4v ca = *(const f32x4v*)tb, cb = *(const f32x4v*)(tb + 4), sa = *(const f32x4v*)(tb + 32), sb = *(const f32x4v*)(tb + 36);
#pragma unroll
            for (int e = 0; e < 8; ++e) { const float cs = e < 4 ? ca[e] : cb[e - 4], sn = e < 4 ? sa[e] : sb[e - 4];
                const float x1 = f1[e] * rn * (e < 4 ? g1a[e] : g1b[e - 4]), x2 = f2[e] * rn * (e < 4 ? g2a[e] : g2b[e - 4]); f1[e] = x1 * cs - x2 * sn; f2[e] = x2 * cs + x1 * sn; }
            u32x4 o1 = {cvtpk(f1[0], f1[1]), cvtpk(f1[2], f1[3]), cvtpk(f1[4], f1[5]), cvtpk(f1[6], f1[7])}, o2 = {cvtpk(f2[0], f2[1]), cvtpk(f2[2], f2[3]), cvtpk(f2[4], f2[5]), cvtpk(f2[6], f2[7])};
            qr[8 + t] = __builtin_bit_cast(bf16x8, o1); qr[10 + t] = __builtin_bit_cast(bf16x8, o2); asm volatile("" : "+v"(qr[8 + t]), "+v"(qr[10 + t])); }
#undef UNPK
    } }
    unsigned ksrc[NKC], vsrc;
#pragma unroll
    for (int i = 0; i < NKC; ++i) { const int p = (wid + 8 * i) * 1024 + lane * 16; const int row = p / KROW, cc = ((p % KROW) >> 4) ^ (row & 7); ksrc[i] = (unsigned)(row * (int)b.ldk + cc * 8); }
    { const int sub = wid * 2 + (lane >> 5); const int kk = (sub >> 2) * 8 + ((lane & 31) >> 2); const int k = (kk & ~0xC) | ((kk & 4) << 1) | ((kk & 8) >> 1);
      vsrc = (unsigned)(k * (int)b.ldv + (sub & 3) * 32 + (lane & 3) * 8); }
    const int vb0 = (int)(uintptr_t)V_lds + v_rd_base(lane);
    ALAS unsigned char* ldsl = ldsp; const unsigned lds0 = (unsigned)(uintptr_t)ldsp;
#define ISSUE_K(t, bf) do { const bf16_t* kt_ = b.K + (size_t)(j_lo + (t)) * KVBLK * b.ldk; \
        _Pragma("unroll") for (int i = 0; i < NKC; ++i) glds16(kt_ + ksrc[i], (unsigned)__builtin_amdgcn_readfirstlane((int)(lds0 + 3 * SHM_V + (bf) * SHM_K + (wid + 8 * i) * 1024))); } while (0)
#define ISSUE_V(t, bf) do { const bf16_t* vt_ = b.V + (size_t)(j_lo + (t)) * KVBLK * b.ldv; \
        _Pragma("unroll") for (int i = 0; i < 2; ++i) glds16(vt_ + (size_t)i * 32 * b.ldv + vsrc, (unsigned)__builtin_amdgcn_readfirstlane((int)(lds0 + (bf) * SHM_V + (wid + 8 * i) * 1024))); } while (0)
#define WAIT_BAR(N) asm volatile("s_waitcnt vmcnt(%0) lgkmcnt(0)\n\ts_barrier" :: "n"(N) : "memory")
    float m_reg = -1e30f, l_reg = 0.f, alpha_c = 1.f; f32x16 o[4] = {}; f32x16 p0, p1;
    int kb4[4];
#pragma unroll
    for (int dd = 0; dd < 4; ++dd) kb4[dd] = KROW * r32 + ((dd * 32 + hi * 16) ^ ((r32 & 7) << 4));
#define ACT(s_) (!WSK || ((j_lo + (s_)) * KVBLK <= qlo + QBLK - 1 && (j_lo + (s_)) * KVBLK + KVBLK - 1 >= qlo - b.W + 1))
#define H1(s_) do { if (!ACT(s_)) break; qk_tile<ND, KROW>(p0, p1, (const ALAS char*)ldsl + 3 * SHM_V + ((s_) % 3) * SHM_K, kb4, qr); \
        const int kb_ = (j_lo + (s_)) * KVBLK; if (kb_ + KVBLK - 1 > qlo || kb_ <= qlo + QBLK - 1 - b.W) mask_tile(p0, p1, qm - kb_, (unsigned)b.W); \
        softmax_p1(p0, p1, m_reg, alpha_c); } while (0)
#define H2(s_) do { if (!ACT(s_)) break; const float alpha = alpha_c; bf16x8 pa0, pa1, pa2, pa3; softmax_p2(p0, p1, alpha, l_reg, pa0, pa1, pa2, pa3); \
        if (__any(alpha < 1.f)) { _Pragma("unroll") for (int d_ = 0; d_ < 4; ++d_) _Pragma("unroll") for (int r = 0; r < 16; ++r) o[d_][r] *= alpha; } \
        SBAR(); pv_tile<(DQK == 128)>(o, vb0 + ((s_) % 3) * SHM_V, pa0, pa1, pa2, pa3); } while (0)
    ISSUE_K(0, 0); ISSUE_V(0, 0);
#pragma unroll
    for (int d0 = 0; d0 < ND; ++d0) asm volatile("" : "+v"(qr[d0]));
    if (NT > 1) { ISSUE_K(1, 1); ISSUE_V(1, 1); WAIT_BAR(NKC + 2); } else { WAIT_BAR(0); }
    if (wid < 4) {
        for (int s = 0; s < NT; ++s) { const bool more2 = s + 2 < NT;
            if (more2) ISSUE_K(s + 2, (s + 2) % 3);
            H1(s);
            if (more2) WAIT_BAR(2 * NKC + 2); else WAIT_BAR(0);
            if (more2) ISSUE_V(s + 2, (s + 2) % 3);
            H2(s);
            if (more2) WAIT_BAR(NKC + 4); else WAIT_BAR(0); }
        WAIT_BAR(0);
    } else {
        if (NT > 2) { ISSUE_K(2, 2); WAIT_BAR(2 * NKC + 2); } else { WAIT_BAR(0); }
        for (int s = 0; s < NT; ++s) { const bool more2 = s + 2 < NT, more3 = s + 3 < NT;
            if (more2) ISSUE_V(s + 2, (s + 2) % 3);
            H1(s);
            if (more2) WAIT_BAR(NKC + 4); else WAIT_BAR(0);
            if (more3) ISSUE_K(s + 3, s % 3);
            H2(s);
            if (more3) WAIT_BAR(2 * NKC + 2); else WAIT_BAR(0); }
    }
#undef H1
#undef ACT
#undef H2
#undef ISSUE_K
#undef ISSUE_V
#undef WAIT_BAR
#undef WAIT_BAR1
#undef WAIT_BAR2
    if (hi == 0 && b.mo) { b.mo[(size_t)(wid * QBLK + r32) * b.ldml] = m_reg; b.lo[(size_t)(wid * QBLK + r32) * b.ldml] = l_reg; }
    { const float rl = __builtin_amdgcn_rcpf(l_reg);
      bf16_t* orow = b.O + (size_t)(wid * QBLK + r32) * b.ldo + hi * 8;
#pragma unroll
      for (int d0 = 0; d0 < 4; ++d0)
#pragma unroll
          for (int j = 0; j < 4; j += 2) {
              unsigned ax = cvtpk(o[d0][4 * j] * rl, o[d0][4 * j + 1] * rl), ay = cvtpk(o[d0][4 * j + 2] * rl, o[d0][4 * j + 3] * rl);
              unsigned bx_ = cvtpk(o[d0][4 * j + 4] * rl, o[d0][4 * j + 5] * rl), by_ = cvtpk(o[d0][4 * j + 6] * rl, o[d0][4 * j + 7] * rl);
              auto r0 = __builtin_amdgcn_permlane32_swap(ax, bx_, false, false); auto r1 = __builtin_amdgcn_permlane32_swap(ay, by_, false, false);
              const u32x4 w = {r0[0], r1[0], r0[1], r1[1]};
              *(u32x4*)(orow + d0 * 32 + j * 8) = w; } }
    __syncthreads();
}
#undef SBAR
}

#define LAS __attribute__((address_space(3)))
typedef unsigned short bf16;
typedef unsigned v4u __attribute__((ext_vector_type(4)));
typedef unsigned v2u __attribute__((ext_vector_type(2)));
typedef float f32x4 __attribute__((ext_vector_type(4)));
constexpr int NWAVES = 8;
constexpr int BATCH = 2, SEQ = 8192, M = BATCH * SEQ, DM = 2048, DFF = 5632, DIN_T = 14336;
constexpr int NPH = 14;
constexpr size_t MiB = 1u << 20;
constexpr size_t WS_SS = 0;
constexpr size_t WS_BAR = 512 * 1024, WS_BAR_BYTES = 16384;
constexpr size_t WS_ML = 1 * MiB;
constexpr size_t WS_WGU = 8 * MiB, WS_WD = 52 * MiB, WS_WIN = 74 * MiB, WS_WUQ = 130 * MiB, WS_WUKV = WS_WUQ + 3 * MiB / 2, WS_WBRM = WS_WUKV + 1 * MiB,
                 WS_WBRD = WS_WBRM + 4 * MiB, WS_WO = WS_WBRD + 4 * MiB, WS_WPG = WS_WO + 8 * MiB, WS_WPP = WS_WPG + 8 * MiB;
constexpr size_t WS_XB = 158 * MiB;
constexpr size_t WS_ODIL = 222 * MiB;
constexpr size_t WS_PB = 254 * MiB;
constexpr size_t WS_R = 262 * MiB;
constexpr size_t WS_ROPE = 550 * MiB;
constexpr size_t WS_END = 554 * MiB;
constexpr size_t R_SMALL = WS_R, R_GATES = WS_R + 32 * MiB, R_Q = WS_R + 160 * MiB, R_K = WS_R + 208 * MiB, R_OMLA = WS_R + 256 * MiB, R_MERGED = R_Q, R_T = WS_R;
constexpr int RING_BYTES = 131072, LDS_BYTES = 147456;
constexpr float LOG2E = 1.4426950408889634f;

struct Args { const void* in[27]; float* out; unsigned char* ws; int ph_lo, ph_hi; };

__device__ __forceinline__ float wave_sum(float v) {
#pragma unroll
    for (int o = 1; o < 64; o <<= 1) v += __shfl_xor(v, o);
    return v;
}
__device__ __forceinline__ unsigned f2bf(float f) { unsigned u = __builtin_bit_cast(unsigned, f); return (u + 0x7fffu + ((u >> 16) & 1u)) >> 16; }
__device__ __forceinline__ unsigned pk2(float lo, float hi) { return f2bf(lo) | (f2bf(hi) << 16); }
__device__ __forceinline__ float bflo(unsigned w) { return __uint_as_float(w << 16); }
__device__ __forceinline__ float bfhi(unsigned w) { return __uint_as_float(w & 0xffff0000u); }
template <int MAP> __device__ __forceinline__ int drow0(int n0) {
    if (MAP == 1) return (n0 >> 7) * 256 + ((n0 & 127) >> 5) * 64;
    if (MAP == 2) return (n0 >> 7) * 256 + ((n0 & 127) >> 5) * 64 + 32;
    if (MAP == 3) return n0 < 832 ? 9216 + n0 : (n0 < 10048 ? n0 - 832 : 10240 + (n0 - 10048));
    return n0;
}
template <int MAP> __device__ __forceinline__ void xpose_item(const float* W, int K, int N, const float* gain, bf16* WT, LAS float* scr, int item, int lane) {
    const int nblk = N / 32, kb = item / nblk, nb = item % nblk, k0 = 64 * kb, n0 = 32 * nb;
    float tv[32];
#pragma unroll
    for (int i = 0; i < 32; ++i) { const int kk = 2 * i + (lane >> 5); tv[i] = W[(size_t)(k0 + kk) * N + n0 + (lane & 31)]; }
#pragma unroll
    for (int i = 0; i < 32; ++i) { const int kk = 2 * i + (lane >> 5); const float gv = gain ? gain[k0 + kk] : 1.f; scr[kk * 33 + (lane & 31)] = tv[i] * gv; }
    asm volatile("s_waitcnt lgkmcnt(0)" ::: "memory");
    const int c = lane & 7, d0 = drow0<MAP>(n0);
#pragma unroll
    for (int j = 0; j < 4; ++j) { const int n = (lane >> 3) + 8 * j; const LAS float* s = scr + (8 * c) * 33 + n;
        v4u o; o.x = pk2(s[0 * 33], s[1 * 33]); o.y = pk2(s[2 * 33], s[3 * 33]); o.z = pk2(s[4 * 33], s[5 * 33]); o.w = pk2(s[6 * 33], s[7 * 33]);
        *(v4u*)(WT + (size_t)(d0 + n) * K + k0 + 8 * c) = o; }
    asm volatile("s_waitcnt lgkmcnt(0)" ::: "memory");
}
struct XJob { const float* W; const float* gain; bf16* WT; int K, N, map; };
__device__ __forceinline__ void xpose_run(const XJob& j, LAS float* scr, int gw, int NGW, int lane, int& base) {
    const int items = (j.K / 64) * (j.N / 32);
    int first = gw - (base % NGW); if (first < 0) first += NGW;
    for (int it = first; it < items; it += NGW) {
        if (j.map == 0) xpose_item<0>(j.W, j.K, j.N, j.gain, j.WT, scr, it, lane);
        else if (j.map == 1) xpose_item<1>(j.W, j.K, j.N, j.gain, j.WT, scr, it, lane);
        else if (j.map == 2) xpose_item<2>(j.W, j.K, j.N, j.gain, j.WT, scr, it, lane);
        else xpose_item<3>(j.W, j.K, j.N, j.gain, j.WT, scr, it, lane);
    }
    base += items;
}
__device__ __forceinline__ void sincos_rev(float ang, float& s, float& c) {
    double rv = (double)ang * 0.15915494309189535; rv -= __builtin_rint(rv); const float f = (float)rv;
    s = __builtin_amdgcn_sinf(f); c = __builtin_amdgcn_cosf(f);
}

typedef unsigned short bf16_dummy_t;
#define XB_TMO      128
#define XB_XCNT(j)  (256  + 64 * (j))
#define XB_XSUB(j)  (1280 + 64 * (j))
#define XB_XGEN(j)  (2304 + 64 * (j))
#define XB_TOP      3328
#define XB_TOPGEN   3392
#define XCD_BAR_WORDS 3456
#define XB_SPIN_CAP (1u << 18)

__device__ __forceinline__ unsigned xb_ld(unsigned* p)              { return __hip_atomic_load(p, __ATOMIC_RELAXED, __HIP_MEMORY_SCOPE_AGENT); }
__device__ __forceinline__ unsigned xb_add(unsigned* p, unsigned v) { return __hip_atomic_fetch_add(p, v, __ATOMIC_RELAXED, __HIP_MEMORY_SCOPE_AGENT); }
__device__ __forceinline__ unsigned xb_xcc_id() { return (unsigned)__builtin_amdgcn_s_getreg((3 << 11) | 20) & 0xFu; }
#define XB_SPIN(cond, bar) do { unsigned _sp = 0; while (cond) { __builtin_amdgcn_s_sleep(1); \
    if ((++_sp & 255u) == 0u) { if (xb_ld(&(bar)[XB_TMO])) break; if (_sp > XB_SPIN_CAP) { atomicAdd(&(bar)[XB_TMO], 1u); break; } } } } while (0)

struct XcdBarrier {
    unsigned* bar; unsigned x;
    volatile LAS unsigned* st;
};

__device__ __forceinline__ XcdBarrier xcd_barrier_post(unsigned* bar, volatile LAS unsigned* st) {
    XcdBarrier b; b.bar = bar; b.x = xb_xcc_id(); b.st = st;
    if (threadIdx.x == 0) (void)xb_add(&bar[XB_XCNT(b.x)], 1u);
    return b;
}
__device__ __forceinline__ void xcd_barrier_complete(unsigned* bar, unsigned x, unsigned& nloc, unsigned& nx) {
    const unsigned G = gridDim.x * gridDim.y * gridDim.z;
    unsigned sum, cnt, mine, sp = 0u;
    for (;;) {
        sum = 0u; cnt = 0u; mine = 0u;
#pragma unroll
        for (unsigned j = 0; j < 16; ++j) { const unsigned c = xb_ld(&bar[XB_XCNT(j)]); sum += c; cnt += (c > 0u) ? 1u : 0u; mine = (j == x) ? c : mine; }
        if (sum == G) break;
        __builtin_amdgcn_s_sleep(1);
        if ((++sp & 255u) == 0u) { if (xb_ld(&bar[XB_TMO])) break; if (sp > XB_SPIN_CAP) { atomicAdd(&bar[XB_TMO], 1u); break; } }
    }
    nloc = mine > 0u ? mine : 1u; nx = cnt > 0u ? cnt : 1u;
}

__device__ __forceinline__ void xcd_barrier(const XcdBarrier& b) {
    asm volatile("s_waitcnt vmcnt(0)" ::: "memory");
    __syncthreads();
    if (threadIdx.x == 0) {
        unsigned* bar = b.bar;
        __builtin_amdgcn_s_waitcnt(0);
        unsigned nloc = b.st[0], nx = b.st[1];
        if (nloc == 0u) { xcd_barrier_complete(bar, b.x, nloc, nx); b.st[0] = nloc; b.st[1] = nx; }
        const unsigned old = xb_add(&bar[XB_XSUB(b.x)], 1u);
        const unsigned gen = old / nloc;
        if (old + 1u == (gen + 1u) * nloc) {
            __builtin_amdgcn_fence(__ATOMIC_RELEASE, "agent");
            asm volatile("s_waitcnt vmcnt(0)" ::: "memory");
            const unsigned og = xb_add(&bar[XB_TOP], 1u);
            const unsigned tg = og / nx;
            if (og + 1u == (tg + 1u) * nx) xb_add(&bar[XB_TOPGEN], 1u);
            else XB_SPIN(xb_ld(&bar[XB_TOPGEN]) == tg, bar);
            __builtin_amdgcn_fence(__ATOMIC_ACQUIRE, "agent");
            xb_add(&bar[XB_XGEN(b.x)], 1u);
            asm volatile("s_waitcnt vmcnt(0)" ::: "memory");
        } else {
            XB_SPIN(xb_ld(&bar[XB_XGEN(b.x)]) == gen, bar);
            __builtin_amdgcn_fence(__ATOMIC_ACQUIRE, "agent");
            asm volatile("s_waitcnt vmcnt(0)" ::: "memory");
        }
    }
    __syncthreads();
}

__device__ __forceinline__ void stagger(int bx, unsigned ticks) {
    const unsigned long long t0 = __builtin_amdgcn_s_memrealtime(); const unsigned long long dl = (unsigned long long)((bx >> 3) & 3) * ticks;
    while (__builtin_amdgcn_s_memrealtime() - t0 < dl) __builtin_amdgcn_s_sleep(8);
}
__global__ void __launch_bounds__(NWAVES * 64, 2) mk_fwd(Args args) {
    extern __shared__ __attribute__((aligned(16))) unsigned char lds[];
    const int wave = __builtin_amdgcn_readfirstlane((int)threadIdx.x >> 6);
#define tid ((int)threadIdx.x)
#define lane ((int)threadIdx.x & 63)
    const int G = gridDim.x, bx = blockIdx.x;
    const int gw = bx * NWAVES + wave, NGW = G * NWAVES;
    unsigned char* ws = args.ws;
#define xin ((const float*)args.in[0])
#define pin ((const float*)args.in[1])
#define positions ((const int*)args.in[2])
#define g_ffn1 ((const float*)args.in[3])
#define w1_gate ((const float*)args.in[4])
#define w1_up ((const float*)args.in[5])
#define w1_down ((const float*)args.in[6])
#define g_mix ((const float*)args.in[7])
#define w_in ((const float*)args.in[8])
#define g_cq ((const float*)args.in[9])
#define w_uq ((const float*)args.in[10])
#define g_ckv ((const float*)args.in[11])
#define w_ukv ((const float*)args.in[12])
#define g_q_mla ((const float*)args.in[13])
#define g_k_mla ((const float*)args.in[14])
#define g_q_dil ((const float*)args.in[15])
#define g_k_dil ((const float*)args.in[16])
#define w_br_mla ((const float*)args.in[17])
#define w_br_dil ((const float*)args.in[18])
#define w_o ((const float*)args.in[19])
#define g_ffn2 ((const float*)args.in[20])
#define w2_gate ((const float*)args.in[21])
#define w2_up ((const float*)args.in[22])
#define w2_down ((const float*)args.in[23])
#define g_ple ((const float*)args.in[24])
#define w_ple_gate ((const float*)args.in[25])
#define w_ple_proj ((const float*)args.in[26])
    float* out = args.out;
    float* ss0 = (float*)(ws + WS_SS); float* ss1 = ss0 + M; float* ss2 = ss0 + 2 * M; float* ss3 = ss0 + 3 * M; float* ss_cq = ss0 + 4 * M; float* ss_ckv = ss0 + 5 * M;
    float* mlm = (float*)(ws + WS_ML); float* mll = mlm + 3 * M * 8;
    bf16* Wgu = (bf16*)(ws + WS_WGU); bf16* Wd = (bf16*)(ws + WS_WD); bf16* Win = (bf16*)(ws + WS_WIN); bf16* Wuq = (bf16*)(ws + WS_WUQ); bf16* Wukv = (bf16*)(ws + WS_WUKV);
    bf16* Wbrm = (bf16*)(ws + WS_WBRM); bf16* Wbrd = (bf16*)(ws + WS_WBRD); bf16* Wo = (bf16*)(ws + WS_WO); bf16* Wpg = (bf16*)(ws + WS_WPG); bf16* Wpp = (bf16*)(ws + WS_WPP);
    bf16* xb = (bf16*)(ws + WS_XB); bf16* kvraw = (bf16*)out;     bf16* odil = (bf16*)(ws + WS_ODIL); bf16* pb = (bf16*)(ws + WS_PB);
    bf16* act = (bf16*)(ws + WS_R); bf16* projd = (bf16*)(ws + WS_R); bf16* smallb = (bf16*)(ws + R_SMALL); bf16* gates = (bf16*)(ws + R_GATES);
    bf16* Qm = (bf16*)(ws + R_Q); bf16* Km = (bf16*)(ws + R_K); bf16* omla = (bf16*)(ws + R_OMLA); bf16* merged = (bf16*)(ws + R_MERGED); bf16* Tb = (bf16*)(ws + R_T);
    LAS unsigned char* ldsl = (LAS unsigned char*)lds;
    LAS float* scr = (LAS float*)(ldsl + wave * 16384);
    const int lo = args.ph_lo, hi = args.ph_hi;
#define SPLIT_LVL 0
#define SPLIT_SCR out
    volatile LAS unsigned* bst = (volatile LAS unsigned*)(ldsl + RING_BYTES);
    if (threadIdx.x < 2) bst[threadIdx.x] = 0u;
    __syncthreads();
    XcdBarrier gbar; gbar.bar = (unsigned*)(ws + WS_BAR); gbar.x = 0; gbar.st = bst;
    if (hi - lo > 1) gbar = xcd_barrier_post((unsigned*)(ws + WS_BAR), bst);
    if (lo < 0) cg::this_grid().sync();
#ifndef PH_MASK
#define PH_MASK 0xffff
#endif
#define IN(k) ((((PH_MASK) >> (k)) & 1) && lo <= (k) && (k) < hi)
#define SEAM(k) do { if (IN(k) && IN((k) + 1)) { xcd_barrier(gbar); } } while (0)

    if (IN(0)) {
        int base = 0;
        { XJob j{w1_gate, g_ffn1, Wgu, DM, DFF, 1}; xpose_run(j, scr, gw, NGW, lane, base); }
        { XJob j{w1_up, g_ffn1, Wgu, DM, DFF, 2}; xpose_run(j, scr, gw, NGW, lane, base); }
        { XJob j{w1_down, nullptr, Wd, DFF, DM, 0}; xpose_run(j, scr, gw, NGW, lane, base); }
        { XJob j{w_in, g_mix, Win, DM, 14144, 3}; xpose_run(j, scr, gw, NGW, lane, base); }
        { XJob j{w_uq, g_cq, Wuq, 512, 1536, 0}; xpose_run(j, scr, gw, NGW, lane, base); }
        { XJob j{w_ukv, g_ckv, Wukv, 256, 2048, 0}; xpose_run(j, scr, gw, NGW, lane, base); }
        { XJob j{w_br_mla, nullptr, Wbrm, 1024, DM, 0}; xpose_run(j, scr, gw, NGW, lane, base); }
        { XJob j{w_br_dil, nullptr, Wbrd, 1024, DM, 0}; xpose_run(j, scr, gw, NGW, lane, base); }
        { XJob j{w_o, nullptr, Wo, DM, DM, 0}; xpose_run(j, scr, gw, NGW, lane, base); }
        { XJob j{w_ple_gate, g_ple, Wpg, DM, DM, 0}; xpose_run(j, scr, gw, NGW, lane, base); }
        { XJob j{w_ple_proj, nullptr, Wpp, 256, DM, 0}; xpose_run(j, scr, gw, NGW, lane, base); }
        for (int m = gw; m < M; m += NGW) {
            const f32x4* xr = (const f32x4*)(xin + (size_t)m * DM) + lane; f32x4 v[8]; float s = 0.f;
#pragma unroll
            for (int j = 0; j < 8; ++j) { v[j] = xr[64 * j]; s += (v[j].x * v[j].x + v[j].y * v[j].y) + (v[j].z * v[j].z + v[j].w * v[j].w); }
            s = wave_sum(s); if (lane == 0) ss0[m] = s;
            v2u* o8 = (v2u*)(xb + (size_t)m * DM) + lane;
#pragma unroll
            for (int j = 0; j < 8; ++j) o8[64 * j] = (v2u){pk2(v[j].x, v[j].y), pk2(v[j].z, v[j].w)};
            const f32x4 pv = *((const f32x4*)(pin + (size_t)m * 256) + lane);
            *((v2u*)(pb + (size_t)m * 256) + lane) = (v2u){pk2(pv.x, pv.y), pk2(pv.z, pv.w)};
        }
        for (int i = bx * 512 + tid; i < 5 * M; i += G * 512) ss1[i] = 0.f;
    }
    SEAM(0);
    if (IN(1)) {
        pg8::Gemm g{xb, Wgu, M, 2 * DFF, DM, DM, DM, nullptr, nullptr}; pg8::SplitOrder S; S.init(M, 2 * DFF, DM, G, bx, SPLIT_LVL, SPLIT_SCR);
        pg8::EpiSwiGLU E{act, DFF, ss0, 1.f / DM};
        pg8::gemm_phase<pg8::EpiSwiGLU, pg8::SplitOrder, true, true>(ldsl, g, S, E);
    }
    SEAM(1);
    if (IN(2)) {
        pg8::Gemm g{act, Wd, M, DM, DFF, DFF, DFF, nullptr, nullptr}; pg8::SplitOrder S; S.init(M, DM, DFF, G, bx, 0, SPLIT_SCR);
        pg8::EpiResid<false> E{xin, xb, ss1, 0.5f};
        pg8::gemm_phase<pg8::EpiResid<false>, pg8::SplitOrder, true, true>(ldsl, g, S, E);
    }
    SEAM(2);
    if (IN(3)) {
        pg8::Gemm g{xb, Win, M, 9216, DM, DM, DM, nullptr, nullptr}; pg8::SplitOrder S; S.init(M, 9216, DM, G, bx, SPLIT_LVL, SPLIT_SCR);
        pg8::EpiScale<0> E{projd, 9216, ss1, 1.f / DM};
        pg8::gemm_phase<pg8::EpiScale<0>, pg8::SplitOrder, true, true>(ldsl, g, S, E);
    }
    SEAM(3);
    if (IN(4)) {
        int base = 0;
        { XJob j{w2_gate, g_ffn2, Wgu, DM, DFF, 1}; xpose_run(j, scr, gw, NGW, lane, base); }
        { XJob j{w2_up, g_ffn2, Wgu, DM, DFF, 2}; xpose_run(j, scr, gw, NGW, lane, base); }
        { XJob j{w2_down, nullptr, Wd, DFF, DM, 0}; xpose_run(j, scr, gw, NGW, lane, base); }
        const int i16 = lane & 15, vsel = lane >> 4;
        for (int tok = gw; tok < M; tok += NGW) {
            const float pos = (float)positions[tok];
            float cs[8], sn[8];
#pragma unroll
            for (int e = 0; e < 8; ++e) { const int jj = 8 * (i16 & 1) + e; const float inv = exp2f(-(float)jj * (1.f / 16.f) * 18.931568569324174f); sincos_rev(pos * inv, sn[e], cs[e]); }
            bf16* tp = projd + (size_t)tok * 9216 + vsel * 128 + i16 * 8;
            v4u wv[12];
#pragma unroll
            for (int c = 0; c < 12; ++c) if ((c >> 1) & 1) wv[c] = *(const v4u*)(tp + (c >> 2) * 3072 + ((c >> 1) & 1) * 1024 + (c & 1) * 512);
#pragma unroll
            for (int c = 0; c < 12; ++c) { const int gi = c >> 2, qk = (c >> 1) & 1; if (!qk) continue;
                const float* gain = (qk ? g_k_dil : g_q_dil) + gi * 128 + i16 * 8;
                const f32x4 ga = *(const f32x4*)gain, gb = *(const f32x4*)(gain + 4);
                const float gsc = qk ? 1.f : 0.08838834764831845f * LOG2E;
                const v4u w = wv[c]; float v[8] = {bflo(w.x), bfhi(w.x), bflo(w.y), bfhi(w.y), bflo(w.z), bfhi(w.z), bflo(w.w), bfhi(w.w)};
                float s = 0.f;
#pragma unroll
                for (int e = 0; e < 8; ++e) s += v[e] * v[e];
                s += __shfl_xor(s, 1); s += __shfl_xor(s, 2); s += __shfl_xor(s, 4); s += __shfl_xor(s, 8);
                const float r = rsqrtf(s * (1.f / 128.f) + 1e-6f);
#pragma unroll
                for (int e = 0; e < 8; ++e) v[e] *= r * (e < 4 ? ga[e] : gb[e - 4]);
#pragma unroll
                for (int e = 0; e < 8; ++e) { const float pr = __shfl_xor(v[e], 2); if (i16 < 4) v[e] = (i16 < 2) ? v[e] * cs[e] - pr * sn[e] : v[e] * cs[e] + pr * sn[e]; }
                v4u o; o.x = pk2(v[0] * gsc, v[1] * gsc); o.y = pk2(v[2] * gsc, v[3] * gsc); o.z = pk2(v[4] * gsc, v[5] * gsc); o.w = pk2(v[6] * gsc, v[7] * gsc);
                *(v4u*)(tp + (c >> 2) * 3072 + ((c >> 1) & 1) * 1024 + (c & 1) * 512) = o; }
        }
    }
    SEAM(4);
    if (IN(5)) {
        for (int it = bx; it < 1536; it += G) {
            const int gi = it / 512, r1 = it % 512, bb = r1 / 256, r2 = r1 % 256, h = r2 / 32, nb = r2 % 32;
            const int dil = gi == 0 ? 1 : (gi == 1 ? 4 : 16), Lg = SEQ / dil, bpp = Lg / 256, ph = nb / bpp, ib = nb % bpp;
            bf16* seq0 = projd + ((size_t)bb * SEQ + ph) * 9216 + gi * 3072 + h * 128;
            att::Blk b; b.ldq = b.ldk = b.ldv = b.ldo = (long)dil * 9216; b.P0 = ib * 256; b.skv = Lg; b.W = 129;
            b.Q = seq0 + (size_t)b.P0 * b.ldq; b.O = seq0 + (size_t)b.P0 * b.ldq; b.K = seq0 + 1024; b.V = seq0 + 2048;
            const size_t tok0 = (size_t)bb * SEQ + ph + (size_t)dil * b.P0;
            b.mo = mlm + ((size_t)gi * M + tok0) * 8 + h; b.lo = mll + ((size_t)gi * M + tok0) * 8 + h; b.ldml = (long)dil * 8;
            b.qgain = g_q_dil + gi * 128; b.qpos = positions + tok0; b.qpstride = dil; b.qtab = nullptr;
            att::attn_block<128>(b, ldsl);
        }
    }
    SEAM(5);
    if (IN(6)) {
        for (int i = bx * 512 + tid; i < 2 * M; i += G * 512) ss_cq[i] = 0.f;
        for (int i = bx * 512 + tid; i < M * 8 * 16; i += G * 512) { const int tok = i >> 7, h = (i >> 4) & 7, c = i & 15;
            float mg[3], lg[3];
#pragma unroll
            for (int gi = 0; gi < 3; ++gi) { mg[gi] = mlm[((size_t)gi * M + tok) * 8 + h]; lg[gi] = mll[((size_t)gi * M + tok) * 8 + h]; }
            const float mx = fmaxf(fmaxf(mg[0], mg[1]), mg[2]); float wsum = 0.f, wg[3];
#pragma unroll
            for (int gi = 0; gi < 3; ++gi) { wg[gi] = lg[gi] * exp2f(mg[gi] - mx); wsum += wg[gi]; }
            const float iw = 1.f / wsum; float a[8] = {0.f, 0.f, 0.f, 0.f, 0.f, 0.f, 0.f, 0.f};
#pragma unroll
            for (int gi = 0; gi < 3; ++gi) { const v4u w = *(const v4u*)(projd + (size_t)tok * 9216 + gi * 3072 + h * 128 + c * 8); const float f = wg[gi] * iw;
                a[0] += f * bflo(w.x); a[1] += f * bfhi(w.x); a[2] += f * bflo(w.y); a[3] += f * bfhi(w.y); a[4] += f * bflo(w.z); a[5] += f * bfhi(w.z); a[6] += f * bflo(w.w); a[7] += f * bfhi(w.w); }
            v4u o; o.x = pk2(a[0], a[1]); o.y = pk2(a[2], a[3]); o.z = pk2(a[4], a[5]); o.w = pk2(a[6], a[7]);
            *(v4u*)(odil + (size_t)tok * 1024 + h * 128 + c * 8) = o; }
    }
    SEAM(6);
    if (IN(7)) {
        pg8::Gemm g{xb, Win + (size_t)9216 * DM, M, 5120, DM, DM, DM, nullptr, nullptr}; pg8::SplitOrder S; S.init(M, 5120, DM, G, bx, 0, SPLIT_SCR);
        pg8::EpiP3b E{smallb, gates, ss1, ss_cq, ss_ckv};
        pg8::gemm_phase<pg8::EpiP3b, pg8::SplitOrder, true, true>(ldsl, g, S, E);
    }
    SEAM(7);
    if (IN(8)) {
        { pg8::Gemm g{smallb, Wuq, M, 1536, 512, 1024, 512, nullptr, nullptr}; pg8::SplitOrder S; S.init(M, 1536, 512, G, bx, 0, nullptr);
          pg8::EpiScale<0> E{Qm, 1536, ss_cq, 1.f / 512.f};
          pg8::gemm_phase<pg8::EpiScale<0>, pg8::SplitOrder, true, true>(ldsl, g, S, E); }
        { pg8::Gemm g{smallb + 512, Wukv, M, 2048, 256, 1024, 256, nullptr, nullptr}; pg8::SplitOrder S; S.init(M, 2048, 256, G, bx, 0, nullptr);
          pg8::EpiScale<0> E{kvraw, 2048, ss_ckv, 1.f / 256.f};
          pg8::gemm_phase<pg8::EpiScale<0>, pg8::SplitOrder, true, true>(ldsl, g, S, E); }
    }
    SEAM(8);
    if (IN(9)) {
        const int jj = lane & 31; const float inv = exp2f(-(float)jj * (1.f / 32.f) * 18.931568569324174f);
        const float gqn0 = g_q_mla[2 * lane], gqn1 = g_q_mla[2 * lane + 1], gqr = g_q_mla[128 + lane];
        const float gkn0 = g_k_mla[2 * lane], gkn1 = g_k_mla[2 * lane + 1], gkr = g_k_mla[128 + lane];
        const float qsc = 0.07216878364870323f * LOG2E;
        for (int tok = gw; tok < M; tok += NGW) {
            float sn, cs; sincos_rev((float)positions[tok] * inv, sn, cs);
            ((float*)(ws + WS_ROPE))[(size_t)tok * 64 + lane] = lane < 32 ? cs : sn;
            const float krv = bflo((unsigned)smallb[(size_t)tok * 1024 + 768 + lane]);
            const bf16* kt = kvraw + (size_t)tok * 2048; bf16* ko = Km + (size_t)tok * 1536;
            unsigned kw[8];
#pragma unroll
            for (int h = 0; h < 8; ++h) kw[h] = *(const unsigned*)(kt + h * 256 + 2 * lane);
#pragma unroll
            for (int h = 0; h < 8; ++h) {
                { float a0 = bflo(kw[h]), a1 = bfhi(kw[h]), ar = krv;
                  const float s = wave_sum(a0 * a0 + a1 * a1 + ar * ar); const float r = rsqrtf(s * (1.f / 192.f) + 1e-6f);
                  a0 *= r * gkn0; a1 *= r * gkn1; ar *= r * gkr; const float pr = __shfl_xor(ar, 32); ar = lane < 32 ? ar * cs - pr * sn : ar * cs + pr * sn;
                  *(unsigned*)(ko + h * 192 + 2 * lane) = pk2(a0, a1); ko[h * 192 + 128 + lane] = (bf16)f2bf(ar); }
            }
        }
    }
    SEAM(9);
    if (IN(10)) {
        for (int it0 = bx; it0 < 256; it0 += G) { const int it = (G == 256) ? ((((it0 & 7) * 2 + (it0 >> 7)) << 4) | ((it0 >> 3) & 15)) : it0;
            const int bh = it >> 4, xq = it & 15, bb = bh >> 3, h = bh & 7;
            for (int ps = 0; ps < 2; ++ps) { const int qb = ps ? 31 - xq : xq;
                att::Blk b; b.ldq = 1536; b.ldk = 1536; b.ldv = 2048; b.ldo = 1024; b.P0 = qb * 256; b.skv = SEQ; b.W = 1 << 30;
                b.Q = Qm + ((size_t)bb * SEQ + b.P0) * 1536 + h * 192; b.K = Km + (size_t)bb * SEQ * 1536 + h * 192; b.V = kvraw + (size_t)bb * SEQ * 2048 + h * 256 + 128;
                b.O = omla + ((size_t)bb * SEQ + b.P0) * 1024 + h * 128; b.mo = nullptr; b.lo = nullptr; b.ldml = 0; b.qgain = g_q_mla; b.qpos = nullptr; b.qpstride = 1; b.qtab = (const float*)(ws + WS_ROPE) + ((size_t)bb * SEQ + b.P0) * 64;
                att::attn_block<192>(b, ldsl); } }
    }
    SEAM(10);
    if (IN(11)) {
        pg8::Gemm g{omla, Wbrm, M, DM, 1024, 1024, 1024, odil, Wbrd}; pg8::ChainOrder S; S.init(M, DM, 1024, G, bx);
        pg8::EpiBrChain E{merged, gates};
        pg8::gemm_phase<pg8::EpiBrChain, pg8::ChainOrder, true, true>(ldsl, g, S, E);
    }
    SEAM(11);
    if (IN(12)) {
        pg8::Gemm g{merged, Wo, M, DM, DM, DM, DM, nullptr, nullptr}; pg8::SplitOrder S; S.init(M, DM, DM, G, bx, 0, SPLIT_SCR);
        pg8::EpiResid<true> E{nullptr, xb, ss2, 1.f};
        pg8::gemm_phase<pg8::EpiResid<true>, pg8::SplitOrder, true, true>(ldsl, g, S, E);
    }
    SEAM(12);
    if (IN(13)) {
        pg8::Gemm g{xb, Wgu, M, 2 * DFF, DM, DM, DM, nullptr, nullptr}; pg8::SplitOrder S; S.init(M, 2 * DFF, DM, G, bx, SPLIT_LVL, SPLIT_SCR);
        pg8::EpiSwiGLU E{act, DFF, ss2, 1.f / DM};
        pg8::gemm_phase<pg8::EpiSwiGLU, pg8::SplitOrder, true, true>(ldsl, g, S, E);
    }
    SEAM(13);
    if (IN(14)) {
        pg8::Gemm g{act, Wd, M, DM, DFF, DFF, DFF, nullptr, nullptr}; pg8::SplitOrder S; S.init(M, DM, DFF, G, bx, 0, SPLIT_SCR);
        pg8::EpiResid<true> E{nullptr, xb, ss3, 0.5f};
        pg8::gemm_phase<pg8::EpiResid<true>, pg8::SplitOrder, true, true>(ldsl, g, S, E);
    }
    SEAM(14);
    if (IN(15)) {
        { pg8::Gemm g{pb, Wpp, M, DM, 256, 256, 256, nullptr, nullptr}; pg8::SplitOrder S; S.init(M, DM, 256, G, bx, 0, (float*)(ws + WS_R + 64 * MiB));
          pg8::EpiScale<0> E{Tb, DM, nullptr, 0.f};
          pg8::gemm_phase<pg8::EpiScale<0>, pg8::SplitOrder, true, true>(ldsl, g, S, E); }
        { pg8::Gemm g{xb, Wpg, M, DM, DM, DM, DM, nullptr, nullptr}; pg8::SplitOrder S; S.init(M, DM, DM, G, bx, 0, (float*)(ws + WS_R + 64 * MiB));
          pg8::EpiPle E{out, xb, Tb, ss3};
          pg8::gemm_phase<pg8::EpiPle, pg8::SplitOrder, true, true>(ldsl, g, S, E); }
    }
#undef IN
#undef SEAM
#undef xin
#undef pin
#undef positions
#undef g_ffn1
#undef w1_gate
#undef w1_up
#undef w1_down
#undef g_mix
#undef w_in
#undef g_cq
#undef w_uq
#undef g_ckv
#undef w_ukv
#undef g_q_mla
#undef g_k_mla
#undef g_q_dil
#undef g_k_dil
#undef w_br_mla
#undef w_br_dil
#undef w_o
#undef g_ffn2
#undef w2_gate
#undef w2_up
#undef w2_down
#undef g_ple
#undef w_ple_gate
#undef w_ple_proj
#undef SPLIT_LVL
#undef SPLIT_SCR
#undef tid
#undef lane
}
constexpr int N_PHASES = 16;

extern "C" void kernel_launch(void* const* d_in, const int* in_sizes, int n_in, void* d_out, int out_size, void* d_ws, size_t ws_size, hipStream_t stream) {
    static int grid = 0;
    if (grid == 0) {
        if (n_in != 27 || out_size != M * DM || ws_size < WS_END) { fprintf(stderr, "kernel_launch: unexpected shapes / workspace (n_in %d out %d ws %zu)\n", n_in, out_size, ws_size); grid = -1; return; }
        int dev = 0, cus = 0, per_cu = 0;
        (void)hipGetDevice(&dev); (void)hipDeviceGetAttribute(&cus, hipDeviceAttributeMultiprocessorCount, dev);
        if (hipFuncSetAttribute((const void*)mk_fwd, hipFuncAttributeMaxDynamicSharedMemorySize, LDS_BYTES) != hipSuccess) { fprintf(stderr, "hipFuncSetAttribute failed\n"); grid = -1; return; }
        if (hipOccupancyMaxActiveBlocksPerMultiprocessor(&per_cu, (const void*)mk_fwd, NWAVES * 64, LDS_BYTES) != hipSuccess || per_cu < 1) { fprintf(stderr, "occupancy query: %d\n", per_cu); per_cu = 1; }
        (void)hipGetLastError();
        grid = cus > 0 ? cus : 256;
    }
    if (grid < 0) return;
    (void)hipMemsetAsync((unsigned char*)d_ws + WS_BAR, 0, WS_BAR_BYTES, stream);
    Args a{};
    for (int i = 0; i < 27; ++i) a.in[i] = d_in[i];
    a.out = (float*)d_out; a.ws = (unsigned char*)d_ws;
#if MK_PER_PHASE
#ifndef DUP_LO
#define DUP_LO 0
#define DUP_HI 0
#define DUP_N 0
#endif
    for (int p = 0; p < N_PHASES; ++p) { a.ph_lo = p; a.ph_hi = p + 1; hipLaunchKernelGGL(mk_fwd, dim3(grid), dim3(NWAVES * 64), LDS_BYTES, stream, a);
        if (p == DUP_HI - 1) for (int rep = 0; rep < DUP_N; ++rep) for (int q = DUP_LO; q < DUP_HI; ++q) { a.ph_lo = q; a.ph_hi = q + 1; hipLaunchKernelGGL(mk_fwd, dim3(grid), dim3(NWAVES * 64), LDS_BYTES, stream, a); } }
#else
    a.ph_lo = 0; a.ph_hi = N_PHASES;
    void* kargs[] = {&a};
    hipError_t e = hipLaunchCooperativeKernel((const void*)mk_fwd, dim3(grid), dim3(NWAVES * 64), kargs, LDS_BYTES, stream);
    if (e != hipSuccess) fprintf(stderr, "cooperative launch failed: %s (grid %d)\n", hipGetErrorString(e), grid);
#endif
}
```

```cpp
#include <hip/hip_runtime.h>
#include <hip/hip_cooperative_groups.h>
#include <cstdio>
#include <cstdint>
namespace cg = cooperative_groups;

#ifndef MK_PER_PHASE
#define MK_PER_PHASE 0
#endif

namespace pg8 {
#define PG8_LAS __attribute__((address_space(3)))
typedef unsigned short bf16_t;
typedef short bf16x8 __attribute__((ext_vector_type(8)));
typedef float f32x4 __attribute__((ext_vector_type(4)));
typedef unsigned u32x4 __attribute__((ext_vector_type(4)));
constexpr int BM = 256, BK = 64, HALF = 128, HTB = HALF * BK * 2  , STAGE_BYTES = 8 * HTB, NXCD = 8, WGM = 8;

__host__ __device__ __forceinline__ int lds_byte(int r, int c) { return (r >> 3) * 1024 + (r & 7) * 128 + ((((c >> 3) ^ (r & 7)) & 7) << 4) + (c & 7) * 2; }
__host__ __device__ __forceinline__ void stage_rc(int b, int& R, int& C) { const int st = b / 1024, sb = b % 1024, rin = sb / 128, chp = (sb % 128) / 16; R = st * 8 + rin; C = ((chp ^ rin) & 7) * 8; }
__host__ __device__ __forceinline__ int perm32(int rho) { const int n = rho >> 4, i = rho & 15; return 8 * (i >> 2) + 4 * n + (i & 3); }

struct Unit { int pm, pn, k0, nk, part; };
struct Gemm { const bf16_t* A; const bf16_t* Bt; int M, N, K, lda, ldb; const bf16_t* A2; const bf16_t* Bt2; };

struct StaticOrder {
    static constexpr bool SPLIT = false, CHAIN = false;
    int nM, nN, nwg, G, c, ntk; float* scratch;
    __host__ __device__ __forceinline__ void init(int M, int N, int G_, int c_, int K_ = 0) { nM = M / BM; nN = N / BM; nwg = nM * nN; G = G_; c = c_; ntk = K_ / BK; scratch = nullptr; }
    __host__ __device__ __forceinline__ bool next(int i, Unit& u) const {
        const long L = (long)i * G + c; if (L >= nwg) return false;
        int wgid = (int)L; { const int q = nwg / NXCD, r = nwg % NXCD, xcd = wgid % NXCD, off = wgid / NXCD; wgid = (xcd < r ? xcd * (q + 1) : r * (q + 1) + (xcd - r) * q) + off; }
        const int nig = WGM * nN, gid = wgid / nig, fm = gid * WGM, gsz = (nM - fm) < WGM ? (nM - fm) : WGM;
        u.pm = fm + ((wgid % nig) % gsz); u.pn = (wgid % nig) / gsz; u.k0 = 0; u.nk = ntk; u.part = 0; return true;
    }
    __device__ __forceinline__ void a_ready(const Unit&) const {}
    __device__ __forceinline__ void done(const Unit&) const {}
};


struct SplitOrder {
    static constexpr bool SPLIT = false, CHAIN = false;
    StaticOrder b; int n, lvl; float* scratch;
    __device__ __forceinline__ void init(int M, int N, int K, int G_, int c_, int lvl_, float* scr) { b.init(M, N, G_, c_, K); scratch = scr; lvl = lvl_; n = (b.nwg - c_ + G_ - 1) / G_; if (n < 0) n = 0; if (n == 0 || (b.ntk % 8) != 0) lvl = 0; }
    __device__ __forceinline__ bool next(int i, Unit& u) const {
        if (lvl == 0) return b.next(i, u);
        if (i == 0) { b.next(0, u); u.nk = lvl * (b.ntk / 4); u.part = 1; return true; }
        if (i < n) return b.next(i, u);
        if (i == n) { b.next(0, u); u.k0 = lvl * (b.ntk / 4); u.nk = b.ntk - u.k0; u.part = 2; return true; }
        return false;
    }
    __device__ __forceinline__ void a_ready(const Unit&) const {}
    __device__ __forceinline__ void done(const Unit&) const {}
};

struct ChainOrder {
    static constexpr bool SPLIT = false, CHAIN = true;
    StaticOrder b; float* scratch;
    __device__ __forceinline__ void init(int M, int N, int K, int G_, int c_) { b.init(M, N, G_, c_, K); scratch = nullptr; }
    __device__ __forceinline__ bool next(int i, Unit& u) const { if (!b.next(i >> 1, u)) return false; u.part = 4 + (i & 1); return true; }
    __device__ __forceinline__ void a_ready(const Unit&) const {}
    __device__ __forceinline__ void done(const Unit&) const {}
};
__device__ __forceinline__ unsigned cvt_pk_bf16(float lo, float hi) { unsigned r; asm volatile("v_cvt_pk_bf16_f32 %0, %1, %2" : "=v"(r) : "v"(lo), "v"(hi)); return r; }
__device__ __forceinline__ float bf_lo(unsigned w) { return __uint_as_float(w << 16); }
__device__ __forceinline__ float bf_hi(unsigned w) { return __uint_as_float(w & 0xffff0000u); }
__device__ __forceinline__ float sigm(float v) { return __builtin_amdgcn_rcpf(1.f + __builtin_amdgcn_exp2f(-1.4426950408889634f * v)); }
__device__ __forceinline__ u32x4 pack8(f32x4 a, f32x4 b) { u32x4 w; w.x = cvt_pk_bf16(a[0], a[1]); w.y = cvt_pk_bf16(a[2], a[3]); w.z = cvt_pk_bf16(b[0], b[1]); w.w = cvt_pk_bf16(b[2], b[3]); return w; }
__device__ __forceinline__ void unpack8(u32x4 w, f32x4& a, f32x4& b) { a = (f32x4){bf_lo(w.x), bf_hi(w.x), bf_lo(w.y), bf_hi(w.y)}; b = (f32x4){bf_lo(w.z), bf_hi(w.z), bf_lo(w.w), bf_hi(w.w)}; }
constexpr float EPSN = 1e-6f;
__device__ __forceinline__ void st_nt16(bf16_t* p, u32x4 v) { __builtin_nontemporal_store(v, (u32x4*)p); }
struct EpiSwiGLU { static constexpr bool PERM = true, AFTER_DRAIN = false, HAS_MID = false;
    bf16_t* O; int ldo; const float* ss; float inv_dim;
    __device__ __forceinline__ void operator()(const f32x4 (&acc)[2][2][4][2], const Unit& u, int wr, int wc, int fr, int fq) const {
        const int col0 = u.pn * 128 + wc * 32 + 8 * fq;
        float rsv[2][4];
#pragma unroll
        for (int ai = 0; ai < 2; ++ai)
#pragma unroll
            for (int m = 0; m < 4; ++m) rsv[ai][m] = ss[u.pm * BM + ai * HALF + wr * 64 + m * 16 + fr];
#pragma unroll
        for (int ai = 0; ai < 2; ++ai)
#pragma unroll
            for (int m = 0; m < 4; ++m) asm volatile("" : "+v"(rsv[ai][m]));
#pragma unroll
        for (int ai = 0; ai < 2; ++ai)
#pragma unroll
            for (int m = 0; m < 4; ++m) { const int row = u.pm * BM + ai * HALF + wr * 64 + m * 16 + fr; const float rs = rsqrtf(rsv[ai][m] * inv_dim + EPSN);
                f32x4 o[2];
#pragma unroll
                for (int n = 0; n < 2; ++n) { const f32x4 g = acc[ai][0][m][n] * rs, up = acc[ai][1][m][n] * rs;
#pragma unroll
                    for (int e = 0; e < 4; ++e) o[n][e] = g[e] * sigm(g[e]) * up[e]; }
                st_nt16(O + (size_t)row * ldo + col0, pack8(o[0], o[1])); }
    }
};
template <bool BF> struct EpiResid { static constexpr bool PERM = true, AFTER_DRAIN = false, HAS_MID = false;
    const float* base; bf16_t* xb; float* ssn; float alpha;
    __device__ __forceinline__ void operator()(const f32x4 (&acc)[2][2][4][2], const Unit& u, int wr, int wc, int fr, int fq) const {
        const int col = u.pn * BM + wc * 64 + 8 * fq;
#pragma unroll
        for (int ai = 0; ai < 2; ++ai) { const int row0 = u.pm * BM + ai * HALF + wr * 64 + fr;
            f32x4 bv[4][2][2];
#pragma unroll
            for (int m = 0; m < 4; ++m)
#pragma unroll
                for (int bj = 0; bj < 2; ++bj) { const size_t off = (size_t)(row0 + m * 16) * 2048 + col + bj * 32;
                    if (BF) unpack8(*(const u32x4*)(xb + off), bv[m][bj][0], bv[m][bj][1]);
                    else { bv[m][bj][0] = *(const f32x4*)(base + off); bv[m][bj][1] = *(const f32x4*)(base + off + 4); } }
#pragma unroll
            for (int m = 0; m < 4; ++m) { const int row = row0 + m * 16; float s = 0.f;
#pragma unroll
                for (int bj = 0; bj < 2; ++bj) { const size_t off = (size_t)row * 2048 + col + bj * 32;
                    const f32x4 v0 = bv[m][bj][0] + acc[ai][bj][m][0] * alpha, v1 = bv[m][bj][1] + acc[ai][bj][m][1] * alpha;
                    *(u32x4*)(xb + off) = pack8(v0, v1);
                    s += (v0[0] * v0[0] + v0[1] * v0[1]) + (v0[2] * v0[2] + v0[3] * v0[3]) + (v1[0] * v1[0] + v1[1] * v1[1]) + (v1[2] * v1[2] + v1[3] * v1[3]); }
                s += __shfl_xor(s, 16); s += __shfl_xor(s, 32);
                if (fq == 0) atomicAdd(ssn + row, s); }
            asm volatile("" ::: "memory"); }
    }
};
template <int ACT> struct EpiScale { static constexpr bool PERM = true, AFTER_DRAIN = false, HAS_MID = false;
    bf16_t* O; int ldc; const float* ss; float inv_dim;
    __device__ __forceinline__ void operator()(const f32x4 (&acc)[2][2][4][2], const Unit& u, int wr, int wc, int fr, int fq) const {
        float rsv[2][4];
#pragma unroll
        for (int ai = 0; ai < 2; ++ai)
#pragma unroll
            for (int m = 0; m < 4; ++m) rsv[ai][m] = ss ? ss[u.pm * BM + ai * HALF + wr * 64 + m * 16 + fr] : 0.f;
#pragma unroll
        for (int ai = 0; ai < 2; ++ai)
#pragma unroll
            for (int m = 0; m < 4; ++m) asm volatile("" : "+v"(rsv[ai][m]));
#pragma unroll
        for (int ai = 0; ai < 2; ++ai)
#pragma unroll
            for (int m = 0; m < 4; ++m) { const int row = u.pm * BM + ai * HALF + wr * 64 + m * 16 + fr; const float rs = ss ? rsqrtf(rsv[ai][m] * inv_dim + EPSN) : 1.f;
#pragma unroll
                for (int bj = 0; bj < 2; ++bj) { f32x4 v0 = acc[ai][bj][m][0] * rs, v1 = acc[ai][bj][m][1] * rs;
                    if (ACT == 1) {
#pragma unroll
                        for (int e = 0; e < 4; ++e) { v0[e] = sigm(v0[e]); v1[e] = sigm(v1[e]); } }
                    st_nt16(O + (size_t)row * ldc + u.pn * BM + wc * 64 + bj * 32 + 8 * fq, pack8(v0, v1)); } }
    }
};
struct EpiP3b { static constexpr bool PERM = true, AFTER_DRAIN = false, HAS_MID = false;
    bf16_t* small; bf16_t* gates; const float* ss; float* ss_cq; float* ss_ckv;
    __device__ __forceinline__ void operator()(const f32x4 (&acc)[2][2][4][2], const Unit& u, int wr, int wc, int fr, int fq) const {
        const bool sm = u.pn < 4; bf16_t* O = sm ? small : gates; const int ldc = sm ? 1024 : 4096, colt = sm ? u.pn * BM : (u.pn - 4) * BM;
        float* ssq = (u.pn < 2) ? ss_cq : (u.pn == 2 ? ss_ckv : nullptr);
        float rsv[2][4];
#pragma unroll
        for (int ai = 0; ai < 2; ++ai)
#pragma unroll
            for (int m = 0; m < 4; ++m) rsv[ai][m] = ss[u.pm * BM + ai * HALF + wr * 64 + m * 16 + fr];
#pragma unroll
        for (int ai = 0; ai < 2; ++ai)
#pragma unroll
            for (int m = 0; m < 4; ++m) asm volatile("" : "+v"(rsv[ai][m]));
#pragma unroll
        for (int ai = 0; ai < 2; ++ai)
#pragma unroll
            for (int m = 0; m < 4; ++m) { const int row = u.pm * BM + ai * HALF + wr * 64 + m * 16 + fr; const float rs = rsqrtf(rsv[ai][m] * (1.f / 2048.f) + EPSN); float s = 0.f;
#pragma unroll
                for (int bj = 0; bj < 2; ++bj) { f32x4 v0 = acc[ai][bj][m][0] * rs, v1 = acc[ai][bj][m][1] * rs;
                    if (!sm) {
#pragma unroll
                        for (int e = 0; e < 4; ++e) { v0[e] = sigm(v0[e]); v1[e] = sigm(v1[e]); } }
                    s += (v0[0] * v0[0] + v0[1] * v0[1]) + (v0[2] * v0[2] + v0[3] * v0[3]) + (v1[0] * v1[0] + v1[1] * v1[1]) + (v1[2] * v1[2] + v1[3] * v1[3]);
                    st_nt16(O + (size_t)row * ldc + colt + wc * 64 + bj * 32 + 8 * fq, pack8(v0, v1)); }
                if (ssq) { s += __shfl_xor(s, 16); s += __shfl_xor(s, 32); if (fq == 0) atomicAdd(ssq + row, s); } }
    }
};
template <bool FIRST> struct EpiBr { static constexpr bool PERM = true, AFTER_DRAIN = false, HAS_MID = false;
    bf16_t* T; const bf16_t* gates;
    __device__ __forceinline__ void operator()(const f32x4 (&acc)[2][2][4][2], const Unit& u, int wr, int wc, int fr, int fq) const {
        const int col = u.pn * BM + wc * 64 + 8 * fq;
#pragma unroll
        for (int ai = 0; ai < 2; ++ai) { const int row0 = u.pm * BM + ai * HALF + wr * 64 + fr;
            u32x4 gv[4][2], tv[4][2];
#pragma unroll
            for (int m = 0; m < 4; ++m)
#pragma unroll
                for (int bj = 0; bj < 2; ++bj) { const int c = col + bj * 32; gv[m][bj] = *(const u32x4*)(gates + (size_t)(row0 + m * 16) * 4096 + (FIRST ? 0 : 2048) + c);
                    if (!FIRST) tv[m][bj] = *(const u32x4*)(T + (size_t)(row0 + m * 16) * 2048 + c); }
#pragma unroll
            for (int m = 0; m < 4; ++m)
#pragma unroll
                for (int bj = 0; bj < 2; ++bj) { f32x4 g0, g1; unpack8(gv[m][bj], g0, g1);
                    f32x4 v0 = acc[ai][bj][m][0] * g0, v1 = acc[ai][bj][m][1] * g1;
                    if (!FIRST) { f32x4 t0, t1; unpack8(tv[m][bj], t0, t1); v0 += t0; v1 += t1; }
                    *(u32x4*)(T + (size_t)(row0 + m * 16) * 2048 + col + bj * 32) = pack8(v0, v1); }
            asm volatile("" ::: "memory"); }
    }
};
struct EpiBrChain { static constexpr bool PERM = true, AFTER_DRAIN = false, HAS_MID = true;
    bf16_t* T; const bf16_t* gates;
    __device__ __forceinline__ void mid(f32x4 (&acc)[2][2][4][2], const Unit& u, int wr, int wc, int fr, int fq) const {
        const int col = u.pn * BM + wc * 64 + 8 * fq;
#pragma unroll
        for (int ai = 0; ai < 2; ++ai)
#pragma unroll
            for (int mp = 0; mp < 2; ++mp) { const int row0 = u.pm * BM + ai * HALF + wr * 64 + mp * 32 + fr;
                u32x4 ga[2][2], gb[2][2];
#pragma unroll
                for (int mm = 0; mm < 2; ++mm)
#pragma unroll
                    for (int bj = 0; bj < 2; ++bj) { const bf16_t* gp = gates + (size_t)(row0 + mm * 16) * 4096 + col + bj * 32; ga[mm][bj] = *(const u32x4*)gp; gb[mm][bj] = *(const u32x4*)(gp + 2048); }
#pragma unroll
                for (int mm = 0; mm < 2; ++mm)
#pragma unroll
                    for (int bj = 0; bj < 2; ++bj) { f32x4 a0, a1, b0, b1; unpack8(ga[mm][bj], a0, a1); unpack8(gb[mm][bj], b0, b1); const int m = mp * 2 + mm;
#pragma unroll
                        for (int e = 0; e < 4; ++e) { acc[ai][bj][m][0][e] *= a0[e] * __builtin_amdgcn_rcpf(fmaxf(b0[e], 1e-30f)); acc[ai][bj][m][1][e] *= a1[e] * __builtin_amdgcn_rcpf(fmaxf(b1[e], 1e-30f)); } }
                asm volatile("" ::: "memory"); }
    }
    __device__ __forceinline__ void operator()(const f32x4 (&acc)[2][2][4][2], const Unit& u, int wr, int wc, int fr, int fq) const {
        const int col = u.pn * BM + wc * 64 + 8 * fq;
#pragma unroll
        for (int ai = 0; ai < 2; ++ai) { const int row0 = u.pm * BM + ai * HALF + wr * 64 + fr;
            u32x4 gb[4][2];
#pragma unroll
            for (int m = 0; m < 4; ++m)
#pragma unroll
                for (int bj = 0; bj < 2; ++bj) gb[m][bj] = *(const u32x4*)(gates + (size_t)(row0 + m * 16) * 4096 + 2048 + col + bj * 32);
#pragma unroll
            for (int m = 0; m < 4; ++m)
#pragma unroll
                for (int bj = 0; bj < 2; ++bj) { f32x4 b0, b1; unpack8(gb[m][bj], b0, b1);
                    *(u32x4*)(T + (size_t)(row0 + m * 16) * 2048 + col + bj * 32) = pack8(acc[ai][bj][m][0] * b0, acc[ai][bj][m][1] * b1); }
            asm volatile("" ::: "memory"); }
    }
};
struct EpiPle { static constexpr bool PERM = true, AFTER_DRAIN = false, HAS_MID = false;
    float* out; const bf16_t* xb; const bf16_t* T; const float* ss;
    __device__ __forceinline__ void operator()(const f32x4 (&acc)[2][2][4][2], const Unit& u, int wr, int wc, int fr, int fq) const {
        const int col = u.pn * BM + wc * 64 + 8 * fq;
        float rsv[2][4];
#pragma unroll
        for (int ai = 0; ai < 2; ++ai)
#pragma unroll
            for (int m = 0; m < 4; ++m) rsv[ai][m] = ss[u.pm * BM + ai * HALF + wr * 64 + m * 16 + fr];
#pragma unroll
        for (int ai = 0; ai < 2; ++ai) { const int row0 = u.pm * BM + ai * HALF + wr * 64 + fr;
            u32x4 tv[4][2], xv[4][2];
#pragma unroll
            for (int m = 0; m < 4; ++m)
#pragma unroll
                for (int bj = 0; bj < 2; ++bj) { const size_t off = (size_t)(row0 + m * 16) * 2048 + col + bj * 32; tv[m][bj] = *(const u32x4*)(T + off); xv[m][bj] = *(const u32x4*)(xb + off); }
#pragma unroll
            for (int m = 0; m < 4; ++m) { const float rs = rsqrtf(rsv[ai][m] * (1.f / 2048.f) + EPSN);
#pragma unroll
                for (int bj = 0; bj < 2; ++bj) { const size_t off = (size_t)(row0 + m * 16) * 2048 + col + bj * 32;
                    f32x4 t0, t1, v0, v1; unpack8(tv[m][bj], t0, t1); unpack8(xv[m][bj], v0, v1);
#pragma unroll
                    for (int e = 0; e < 4; ++e) { v0[e] += sigm(acc[ai][bj][m][0][e] * rs) * t0[e]; v1[e] += sigm(acc[ai][bj][m][1][e] * rs) * t1[e]; }
                    __builtin_nontemporal_store(v0, (f32x4*)(out + off)); __builtin_nontemporal_store(v1, (f32x4*)(out + off + 4)); } }
            asm volatile("" ::: "memory"); }
    }
};
template <class Epi, class Sched, bool ALIGN_EPI = false, bool SP2 = false>
__device__ __forceinline__ void gemm_phase(PG8_LAS unsigned char* lds, const Gemm g, const Sched& S, const Epi& E) {
    const int tid = threadIdx.x, wid = __builtin_amdgcn_readfirstlane(tid >> 6), lane = tid & 63, wr = wid >> 2, wc = wid & 3, fr = lane & 15, fq = lane >> 4;
    int K = g.K; asm volatile("" : "+s"(K)); const int nt = K / BK;
    unsigned voffA[2], voffB[2];
#pragma unroll
    for (int i = 0; i < 2; ++i) { int R, C; stage_rc(tid * 16 + i * 8192, R, C); const int Rb = Epi::PERM ? ((R >> 5) * 64 + perm32(R & 31)) : R;
        voffA[i] = (unsigned)(R * g.lda + C) * 2u; voffB[i] = (unsigned)(Rb * g.ldb + C) * 2u; }
    const size_t kstep = (size_t)(BK * 2);
    const size_t hstepA = (size_t)HALF * g.lda * 2, hstepB = (size_t)(Epi::PERM ? 32 : HALF) * g.ldb * 2;
    const size_t tstepA = 2 * hstepA, tstepB = (size_t)BM * g.ldb * 2;
    const unsigned ldsw = (unsigned)wid * 1024u;
    const int aoff = lds_byte(wr * 64 + fr, fq * 8), boff = lds_byte(wc * 32 + fr, fq * 8);
#define PG8_SA(b, h) (((b) * 2 + (h)) * HTB)
#define PG8_SB(b, h) ((4 + (b) * 2 + (h)) * HTB)
#define PG8_STAGE(bufoff, gbase, voff) do { _Pragma("unroll") for (int _i = 0; _i < 2; ++_i) \
        __builtin_amdgcn_global_load_lds((const unsigned*)((const char*)(gbase) + (voff)[_i]), (PG8_LAS unsigned*)(lds + (bufoff) + ldsw + _i * 8192), 16, 0, 0); } while (0)
#define PG8_LDA(dst, b, h) do { _Pragma("unroll") for (int m = 0; m < 4; ++m) _Pragma("unroll") for (int k = 0; k < 2; ++k) dst[m][k] = *(const PG8_LAS bf16x8*)(lds + PG8_SA(b, h) + (aoff ^ (k << 6)) + m * 2048); } while (0)
#define PG8_LDB(dst, b, h) do { _Pragma("unroll") for (int n = 0; n < 2; ++n) _Pragma("unroll") for (int k = 0; k < 2; ++k) dst[n][k] = *(const PG8_LAS bf16x8*)(lds + PG8_SB(b, h) + (boff ^ (k << 6)) + n * 2048); } while (0)
#define PG8_MMA(ai, bj, At, Bt) do { __builtin_amdgcn_s_setprio(1); _Pragma("unroll") for (int m = 0; m < 4; ++m) _Pragma("unroll") for (int n = 0; n < 2; ++n) _Pragma("unroll") for (int k = 0; k < 2; ++k) \
        acc[ai][bj][m][n] = __builtin_amdgcn_mfma_f32_16x16x32_bf16(Bt[n][k], At[m][k], acc[ai][bj][m][n], 0, 0, 0); __builtin_amdgcn_s_setprio(0); } while (0)
#define PG8_WAIT_V(n) asm volatile("s_waitcnt vmcnt(" #n ")" ::: "memory")
#define PG8_WAIT_L(n) asm volatile("s_waitcnt lgkmcnt(" #n ")" ::: "memory")
#define PG8_BAR __builtin_amdgcn_s_barrier()
#define PG8_SCHED __builtin_amdgcn_sched_barrier(0)
    Unit cur, nxt; int ui = 0;
    if (!S.next(0, cur)) return;
    f32x4 acc[2][2][4][2];
#pragma unroll
    for (int a = 0; a < 2; ++a)
#pragma unroll
        for (int b = 0; b < 2; ++b)
#pragma unroll
            for (int m = 0; m < 4; ++m)
#pragma unroll
                for (int n = 0; n < 2; ++n) acc[a][b][m][n] = (f32x4){0.f, 0.f, 0.f, 0.f};
    bf16x8 At[4][2], B0[2][2], B1[2][2];
    const char* cA = (const char*)(Sched::CHAIN && cur.part == 5 ? g.A2 : g.A) + (size_t)cur.pm * tstepA + (size_t)cur.k0 * kstep; const char* cB = (const char*)(Sched::CHAIN && cur.part == 5 ? g.Bt2 : g.Bt) + (size_t)cur.pn * tstepB + (size_t)cur.k0 * kstep;
    S.a_ready(cur);
    if constexpr (SP2) {
        PG8_STAGE(PG8_SB(0, 0), cB, voffB); PG8_STAGE(PG8_SB(0, 1), cB + hstepB, voffB); PG8_STAGE(PG8_SA(0, 0), cA, voffA); PG8_STAGE(PG8_SA(0, 1), cA + hstepA, voffA);
        if (wr == 1) PG8_BAR;
        PG8_WAIT_V(2); PG8_BAR;
        PG8_STAGE(PG8_SB(1, 0), cB + kstep, voffB); PG8_STAGE(PG8_SA(1, 0), cA + kstep, voffA); PG8_STAGE(PG8_SB(1, 1), cB + hstepB + kstep, voffB);
        PG8_WAIT_V(6); PG8_BAR;
    } else {
        PG8_STAGE(PG8_SB(0, 0), cB, voffB); PG8_STAGE(PG8_SA(0, 0), cA, voffA); PG8_STAGE(PG8_SB(0, 1), cB + hstepB, voffB); PG8_STAGE(PG8_SA(0, 1), cA + hstepA, voffA);
        if (wr == 1) PG8_BAR;
        PG8_WAIT_V(4); PG8_BAR;
        PG8_STAGE(PG8_SB(1, 0), cB + kstep, voffB); PG8_STAGE(PG8_SA(1, 0), cA + kstep, voffA); PG8_STAGE(PG8_SB(1, 1), cB + hstepB + kstep, voffB);
        PG8_WAIT_V(6); PG8_BAR;
    }
    for (;;) {
        const bool has_next = S.next(ui + 1, nxt);
        const char* nA = has_next ? (const char*)(Sched::CHAIN && nxt.part == 5 ? g.A2 : g.A) + (size_t)nxt.pm * tstepA + (size_t)nxt.k0 * kstep : cA; const char* nB = has_next ? (const char*)(Sched::CHAIN && nxt.part == 5 ? g.Bt2 : g.Bt) + (size_t)nxt.pn * tstepB + (size_t)nxt.k0 * kstep : cB;
        int ntu = cur.nk; asm volatile("" : "+v"(ntu)); ntu = __builtin_amdgcn_readfirstlane(ntu);
        for (int t = 0; t < ntu; t += 2) {
            const bool last = (t == ntu - 2);
            const char* a1 = cA + (size_t)(t + 1) * kstep;
            const char* a2 = last ? nA : cA + (size_t)(t + 2) * kstep; const char* b2 = last ? nB : cB + (size_t)(t + 2) * kstep;
            const char* a3 = a2 + kstep; const char* b3 = b2 + kstep;
            if (last && has_next) S.a_ready(nxt);
            if constexpr (SP2) {
            PG8_LDB(B0, 0, 0); PG8_LDB(B1, 0, 1); PG8_SCHED; PG8_LDA(At, 0, 0); PG8_STAGE(PG8_SA(1, 1), a1 + hstepA, voffA);
            PG8_WAIT_V(8); PG8_WAIT_L(0); PG8_BAR; PG8_MMA(0, 0, At, B0); PG8_MMA(0, 1, At, B1); PG8_BAR; PG8_SCHED;
            PG8_LDA(At, 0, 1); PG8_STAGE(PG8_SB(0, 0), b2, voffB); PG8_STAGE(PG8_SB(0, 1), b2 + hstepB, voffB); PG8_STAGE(PG8_SA(0, 0), a2, voffA);
            PG8_WAIT_V(8); PG8_WAIT_L(0); PG8_BAR; PG8_MMA(1, 0, At, B0); PG8_MMA(1, 1, At, B1); PG8_BAR; PG8_SCHED;
            PG8_LDB(B0, 1, 0); PG8_LDB(B1, 1, 1); PG8_SCHED; PG8_LDA(At, 1, 0); PG8_STAGE(PG8_SA(0, 1), a2 + hstepA, voffA);
            PG8_WAIT_V(8); PG8_WAIT_L(0); PG8_BAR; PG8_MMA(0, 0, At, B0); PG8_MMA(0, 1, At, B1); PG8_BAR; PG8_SCHED;
            PG8_LDA(At, 1, 1); PG8_STAGE(PG8_SB(1, 0), b3, voffB); PG8_STAGE(PG8_SB(1, 1), b3 + hstepB, voffB); PG8_STAGE(PG8_SA(1, 0), a3, voffA);
            PG8_WAIT_V(8); PG8_WAIT_L(0); PG8_BAR; PG8_MMA(1, 0, At, B0); PG8_MMA(1, 1, At, B1); PG8_BAR; PG8_SCHED;
            } else {
            PG8_LDB(B0, 0, 0); PG8_SCHED; PG8_LDA(At, 0, 0); PG8_STAGE(PG8_SA(1, 1), a1 + hstepA, voffA);
            PG8_WAIT_L(8); PG8_BAR; PG8_WAIT_L(0); PG8_MMA(0, 0, At, B0); PG8_BAR; PG8_SCHED;
            PG8_LDB(B1, 0, 1); PG8_STAGE(PG8_SB(0, 0), b2, voffB);
            PG8_BAR; PG8_WAIT_L(0); PG8_MMA(0, 1, At, B1); PG8_BAR;
            PG8_LDA(At, 0, 1); PG8_STAGE(PG8_SA(0, 0), a2, voffA);
            PG8_BAR; PG8_WAIT_L(0); PG8_MMA(1, 0, At, B0); PG8_BAR; PG8_SCHED;
            PG8_STAGE(PG8_SB(0, 1), b2 + hstepB, voffB);
            PG8_WAIT_V(6); PG8_BAR; PG8_MMA(1, 1, At, B1); PG8_BAR;
            PG8_LDB(B0, 1, 0); PG8_SCHED; PG8_LDA(At, 1, 0); PG8_STAGE(PG8_SA(0, 1), a2 + hstepA, voffA);
            PG8_WAIT_L(8); PG8_BAR; PG8_WAIT_L(0); PG8_MMA(0, 0, At, B0); PG8_BAR; PG8_SCHED;
            PG8_LDB(B1, 1, 1); PG8_STAGE(PG8_SB(1, 0), b3, voffB);
            PG8_BAR; PG8_WAIT_L(0); PG8_MMA(0, 1, At, B1); PG8_BAR;
            PG8_LDA(At, 1, 1); PG8_STAGE(PG8_SA(1, 0), a3, voffA);
            PG8_BAR; PG8_WAIT_L(0); PG8_MMA(1, 0, At, B0); PG8_BAR; PG8_SCHED;
            PG8_STAGE(PG8_SB(1, 1), b3 + hstepB, voffB);
            PG8_WAIT_V(6); PG8_BAR; PG8_MMA(1, 1, At, B1); PG8_BAR;
            }
        }
        if constexpr (ALIGN_EPI) { if (wr == 0) PG8_BAR; }
        if constexpr (!Epi::AFTER_DRAIN) {
            if (Sched::SPLIT && cur.part == 1) {
                f32x4* sp = (f32x4*)S.scratch + (size_t)blockIdx.x * (32 * BM * 2) + tid;
#pragma unroll
                for (int a = 0; a < 2; ++a)
#pragma unroll
                    for (int b = 0; b < 2; ++b)
#pragma unroll
                        for (int m = 0; m < 4; ++m)
#pragma unroll
                            for (int n = 0; n < 2; ++n) { *sp = acc[a][b][m][n]; sp += BM * 2; asm volatile("" : "+v"(sp)); }
            } else if (Sched::CHAIN && cur.part == 4) { if constexpr (Epi::HAS_MID) E.mid(acc, cur, wr, wc, fr, fq); }
            else { E(acc, cur, wr, wc, fr, fq); }
            S.done(cur); }
        if (!has_next) break;
        if (!(Sched::CHAIN && cur.part == 4))
#pragma unroll
        for (int a = 0; a < 2; ++a)
#pragma unroll
            for (int b = 0; b < 2; ++b)
#pragma unroll
                for (int m = 0; m < 4; ++m)
#pragma unroll
                    for (int n = 0; n < 2; ++n) acc[a][b][m][n] = (f32x4){0.f, 0.f, 0.f, 0.f};
        if (Sched::SPLIT && nxt.part == 2) {
            const f32x4* sp = (const f32x4*)S.scratch + (size_t)blockIdx.x * (32 * BM * 2) + tid;
#pragma unroll
            for (int a = 0; a < 2; ++a)
#pragma unroll
                for (int b = 0; b < 2; ++b)
#pragma unroll
                    for (int m = 0; m < 4; ++m)
#pragma unroll
                        for (int n = 0; n < 2; ++n) { acc[a][b][m][n] = *sp; sp += BM * 2; asm volatile("" : "+v"(sp)); }
        }
        cur = nxt; cA = nA; cB = nB; ++ui;
        if constexpr (ALIGN_EPI) { if (wr == 1) PG8_BAR; }
    }
    PG8_WAIT_V(0);
    if constexpr (!ALIGN_EPI) { if (wr == 0) PG8_BAR; }
    PG8_BAR;
    if constexpr (Epi::AFTER_DRAIN) { E.fused(acc, cur, wr, wc, fr, fq, lds, wid, lane); S.done(cur); }
#undef PG8_SA
#undef PG8_SB
#undef PG8_STAGE
#undef PG8_LDA
#undef PG8_LDB
#undef PG8_MMA
#undef PG8_WAIT_V
#undef PG8_WAIT_L
#undef PG8_BAR
#undef PG8_SCHED
}
}

namespace att {
typedef unsigned short bf16_t;
typedef short bf16x8 __attribute__((ext_vector_type(8)));
typedef short s16x4 __attribute__((ext_vector_type(4)));
typedef float f32x16 __attribute__((ext_vector_type(16)));
typedef unsigned u32x4 __attribute__((ext_vector_type(4)));
typedef float f32x4v __attribute__((ext_vector_type(4)));
constexpr int NW = 8, QBLK = 32, KVBLK = 64, QB = 256, SHM_V = 16384;
constexpr float THR = 8.f;
#define ALAS __attribute__((address_space(3)))
#define SBAR() __builtin_amdgcn_sched_barrier(0)
__device__ __forceinline__ int v_st(int k, int c) { const int kk = (k & ~0xC) | ((k & 4) << 1) | ((k & 8) >> 1); return ((kk >> 3) * 4 + (c >> 5)) * 512 + ((kk & 7) * 32 + (c & 31)) * 2; }
__device__ __forceinline__ int v_rd_base(int lane) { return ((lane & 3) << 3) | (((lane >> 2) & 3) << 6) | (((lane >> 4) & 1) << 5) | (((lane >> 5) & 1) << 8); }
constexpr int v_rd_off(int d0, int ks, int half) { return d0 * 512 + ks * 4096 + half * 2048; }
__device__ __forceinline__ int crow(int r, int hi) { return (r & 3) + 8 * (r >> 2) + 4 * hi; }
__device__ __forceinline__ unsigned cvtpk(float lo, float hi) { unsigned r; asm volatile("v_cvt_pk_bf16_f32 %0, %1, %2" : "=v"(r) : "v"(lo), "v"(hi)); return r; }
__device__ __forceinline__ void glds16(const void* gsrc, unsigned lds_dst) { unsigned keep;
    asm volatile("s_mov_b32 %0, m0\n\ts_mov_b32 m0, %2\n\ts_nop 0\n\tglobal_load_lds_dwordx4 %1, off\n\ts_mov_b32 m0, %0" : "=&s"(keep) : "v"(gsrc), "s"(lds_dst) : "memory"); }
__device__ __forceinline__ void mask_tile(f32x16& p0, f32x16& p1, int dq, unsigned W) {
    const float NEG = -__builtin_inff();
#pragma unroll
    for (int r = 0; r < 16; ++r) { const int c = (r & 3) + 8 * (r >> 2);
        if ((unsigned)(dq - c) >= W) p0[r] = NEG;
        if ((unsigned)(dq - c - 32) >= W) p1[r] = NEG; }
}
__device__ __forceinline__ void softmax_p1(f32x16& p0, f32x16& p1, float& m_reg, float& alpha) {
    float pa = fmaxf(p0[0], p0[1]), pb = fmaxf(p0[2], p0[3]), pc = fmaxf(p1[0], p1[1]), pd = fmaxf(p1[2], p1[3]);
#pragma unroll
    for (int r = 4; r < 16; r += 4) { pa = fmaxf(pa, fmaxf(p0[r], p0[r + 1])); pb = fmaxf(pb, fmaxf(p0[r + 2], p0[r + 3])); pc = fmaxf(pc, fmaxf(p1[r], p1[r + 1])); pd = fmaxf(pd, fmaxf(p1[r + 2], p1[r + 3])); }
    float pmax = fmaxf(fmaxf(pa, pb), fmaxf(pc, pd));
    { auto rr = __builtin_amdgcn_permlane32_swap(__float_as_uint(pmax), __float_as_uint(pmax), false, false); pmax = fmaxf(__uint_as_float(rr[0]), __uint_as_float(rr[1])); }
    float mn;
    if (__builtin_expect(__all((pmax - m_reg) <= THR), 1)) { mn = m_reg; alpha = 1.f; }
    else { mn = fmaxf(m_reg, pmax); alpha = __builtin_amdgcn_exp2f(m_reg - mn); m_reg = mn; }
#pragma unroll
    for (int r = 0; r < 16; ++r) { p0[r] = __builtin_amdgcn_exp2f(p0[r] - mn); p1[r] = __builtin_amdgcn_exp2f(p1[r] - mn); }
}
__device__ __forceinline__ void softmax_p2(f32x16& p0, f32x16& p1, float alpha, float& l_reg, bf16x8& pa0, bf16x8& pa1, bf16x8& pa2, bf16x8& pa3) {
    float sa = 0.f, sb = 0.f, sc = 0.f, sd = 0.f;
#pragma unroll
    for (int r = 0; r < 16; r += 2) { sa += p0[r]; sb += p0[r + 1]; sc += p1[r]; sd += p1[r + 1]; }
    float ps = (sa + sb) + (sc + sd);
    { auto rr = __builtin_amdgcn_permlane32_swap(__float_as_uint(ps), __float_as_uint(ps), false, false); ps = __uint_as_float(rr[0]) + __uint_as_float(rr[1]); }
    l_reg = l_reg * alpha + ps;
#define PK4(P, B_, OUT) do { unsigned a0 = cvtpk(P[B_+0], P[B_+1]), a1 = cvtpk(P[B_+2], P[B_+3]); unsigned b0 = cvtpk(P[B_+4], P[B_+5]), b1 = cvtpk(P[B_+6], P[B_+7]); \
        auto r0 = __builtin_amdgcn_permlane32_swap(a0, b0, false, false); auto r1 = __builtin_amdgcn_permlane32_swap(a1, b1, false, false); \
        u32x4 w = {r0[0], r1[0], r0[1], r1[1]}; OUT = *reinterpret_cast<bf16x8*>(&w); } while (0)
    PK4(p0, 0, pa0); PK4(p0, 8, pa1); PK4(p1, 0, pa2); PK4(p1, 8, pa3);
#undef PK4
}
template <bool PF> __device__ __forceinline__ void pv_tile(f32x16* o, int vb0, bf16x8 pa0, bf16x8 pa1, bf16x8 pa2, bf16x8 pa3) {
#define TRRD(dst, off) asm volatile("ds_read_b64_tr_b16 %0, %1 offset:%2" : "=&v"(dst) : "v"(vb0), "i"(off) : "memory")
#define RD8(L, d0) do { constexpr int b_ = v_rd_off(d0, 0, 0); TRRD(L[0], b_); TRRD(L[1], b_ + 2048); TRRD(L[2], b_ + 4096); TRRD(L[3], b_ + 6144); TRRD(L[4], b_ + 8192); TRRD(L[5], b_ + 10240); TRRD(L[6], b_ + 12288); TRRD(L[7], b_ + 14336); } while (0)
#define MM4(L, d0) do { \
        o[d0] = __builtin_amdgcn_mfma_f32_32x32x16_bf16(pa0, (bf16x8){L[0][0], L[0][1], L[0][2], L[0][3], L[1][0], L[1][1], L[1][2], L[1][3]}, o[d0], 0, 0, 0); \
        o[d0] = __builtin_amdgcn_mfma_f32_32x32x16_bf16(pa1, (bf16x8){L[2][0], L[2][1], L[2][2], L[2][3], L[3][0], L[3][1], L[3][2], L[3][3]}, o[d0], 0, 0, 0); \
        o[d0] = __builtin_amdgcn_mfma_f32_32x32x16_bf16(pa2, (bf16x8){L[4][0], L[4][1], L[4][2], L[4][3], L[5][0], L[5][1], L[5][2], L[5][3]}, o[d0], 0, 0, 0); \
        o[d0] = __builtin_amdgcn_mfma_f32_32x32x16_bf16(pa3, (bf16x8){L[6][0], L[6][1], L[6][2], L[6][3], L[7][0], L[7][1], L[7][2], L[7][3]}, o[d0], 0, 0, 0); } while (0)
    if constexpr (PF) {
    s16x4 A[8], B[8];
    RD8(A, 0); RD8(B, 1);
    asm volatile("s_waitcnt lgkmcnt(8)" ::: "memory"); SBAR(); MM4(A, 0); SBAR();
    RD8(A, 2);
    asm volatile("s_waitcnt lgkmcnt(8)" ::: "memory"); SBAR(); MM4(B, 1); SBAR();
    RD8(B, 3);
    asm volatile("s_waitcnt lgkmcnt(8)" ::: "memory"); SBAR(); MM4(A, 2); SBAR();
    asm volatile("s_waitcnt lgkmcnt(0)" ::: "memory"); SBAR(); MM4(B, 3);
    } else {
    s16x4 A[8];
    RD8(A, 0); asm volatile("s_waitcnt lgkmcnt(0)" ::: "memory"); SBAR(); MM4(A, 0); SBAR();
    RD8(A, 1); asm volatile("s_waitcnt lgkmcnt(0)" ::: "memory"); SBAR(); MM4(A, 1); SBAR();
    RD8(A, 2); asm volatile("s_waitcnt lgkmcnt(0)" ::: "memory"); SBAR(); MM4(A, 2); SBAR();
    RD8(A, 3); asm volatile("s_waitcnt lgkmcnt(0)" ::: "memory"); SBAR(); MM4(A, 3);
    }
#undef MM4
#undef RD8
#undef TRRD
}
template <int ND, int KROW> __device__ __forceinline__ void qk_tile(f32x16& p0, f32x16& p1, const ALAS char* Kb, const int (&kb4)[4], const bf16x8* qr) {
    bf16x8 R[3][2];
#define LDK(slot, d0) do { const ALAS char* ka = Kb + kb4[(d0) & 3] + ((d0) >> 2) * 128; R[slot][0] = *(const ALAS bf16x8*)(ka); R[slot][1] = *(const ALAS bf16x8*)(ka + 32 * KROW); } while (0)
    LDK(0, 0); LDK(1, 1); LDK(2, 2);
    p0 = f32x16{}; p1 = f32x16{};
#pragma unroll
    for (int d0 = 0; d0 < ND; ++d0) {
        SBAR();
        p0 = __builtin_amdgcn_mfma_f32_32x32x16_bf16(R[d0 % 3][0], qr[d0], p0, 0, 0, 0); p1 = __builtin_amdgcn_mfma_f32_32x32x16_bf16(R[d0 % 3][1], qr[d0], p1, 0, 0, 0);
        SBAR();
        if (d0 + 3 < ND) LDK(d0 % 3, d0 + 3);
    }
#undef LDK
}
struct Blk { const bf16_t* Q; const bf16_t* K; const bf16_t* V; bf16_t* O; long ldq, ldk, ldv, ldo; int P0, skv, W; float* mo; float* lo; long ldml;
             const float* qgain; const int* qpos; int qpstride; const float* qtab; };
template <int DQK>
__device__ __forceinline__ void attn_block(const Blk& b, ALAS unsigned char* ldsp) {
    char* lds = (char*)ldsp;
    constexpr bool WSK = (DQK == 128);
    constexpr int ND = DQK / 16, KROW = DQK * 2, SHM_K = 64 * KROW, CPR = DQK / 8, NKC = (64 * CPR) / 512;
    const int tid = threadIdx.x, wid = __builtin_amdgcn_readfirstlane(tid >> 6), lane = tid & 63, r32 = lane & 31, hi = lane >> 5;
    char* V_lds = lds; char* K_lds = lds + 3 * SHM_V; float* ws = (float*)(lds + 3 * SHM_V + 3 * SHM_K) + wid * 64;
    const int lowk = b.P0 - b.W + 1; const int j_lo = lowk > 0 ? lowk / KVBLK : 0;
    int j_hi = (b.P0 + QB - 1) / KVBLK + 1; if (j_hi > b.skv / KVBLK) j_hi = b.skv / KVBLK;
    const int NT = j_hi - j_lo;
    const int qlo = b.P0 + wid * QBLK, qm = qlo + r32 - 4 * hi;
    bf16x8 qr[ND];
#pragma unroll
    for (int d0 = 0; d0 < ND; ++d0) qr[d0] = *(const bf16x8*)(b.Q + (size_t)(wid * QBLK + r32) * b.ldq + d0 * 16 + hi * 8);
    if constexpr (DQK == 128) { if (b.qgain) {
        float qf[8][8]; float ssq = 0.f;
#pragma unroll
        for (int d0 = 0; d0 < 8; ++d0) { const u32x4 w = __builtin_bit_cast(u32x4, qr[d0]);
            qf[d0][0] = __uint_as_float(w.x << 16); qf[d0][1] = __uint_as_float(w.x & 0xffff0000u); qf[d0][2] = __uint_as_float(w.y << 16); qf[d0][3] = __uint_as_float(w.y & 0xffff0000u);
            qf[d0][4] = __uint_as_float(w.z << 16); qf[d0][5] = __uint_as_float(w.z & 0xffff0000u); qf[d0][6] = __uint_as_float(w.w << 16); qf[d0][7] = __uint_as_float(w.w & 0xffff0000u);
#pragma unroll
            for (int e = 0; e < 8; ++e) ssq += qf[d0][e] * qf[d0][e]; }
        { auto rr = __builtin_amdgcn_permlane32_swap(__float_as_uint(ssq), __float_as_uint(ssq), false, false); ssq = __uint_as_float(rr[0]) + __uint_as_float(rr[1]); }
        const float rn = rsqrtf(ssq * (1.f / 128.f) + 1e-6f) * (0.08838834764831845f * 1.4426950408889634f);
        const float pos = (float)b.qpos[(size_t)(wid * QBLK + r32) * b.qpstride];
#pragma unroll
        for (int d0 = 0; d0 < 8; ++d0) { const f32x4v ga = *(const f32x4v*)(b.qgain + d0 * 16 + hi * 8), gb = *(const f32x4v*)(b.qgain + d0 * 16 + hi * 8 + 4);
#pragma unroll
            for (int e = 0; e < 8; ++e) qf[d0][e] *= rn * (e < 4 ? ga[e] : gb[e - 4]); }
#pragma unroll
        for (int e = 0; e < 8; ++e) { const int jj = 8 * hi + e; const float inv = exp2f(-(float)jj * (1.f / 16.f) * 18.931568569324174f);
            double rv = (double)(pos * inv) * 0.15915494309189535; rv -= __builtin_rint(rv); const float fr_ = (float)rv; const float sn = __builtin_amdgcn_sinf(fr_), cs = __builtin_amdgcn_cosf(fr_);
            const float x1 = qf[0][e], x2 = qf[1][e]; qf[0][e] = x1 * cs - x2 * sn; qf[1][e] = x2 * cs + x1 * sn; }
#pragma unroll
        for (int d0 = 0; d0 < 8; ++d0) { u32x4 w = {cvtpk(qf[d0][0], qf[d0][1]), cvtpk(qf[d0][2], qf[d0][3]), cvtpk(qf[d0][4], qf[d0][5]), cvtpk(qf[d0][6], qf[d0][7])}; qr[d0] = __builtin_bit_cast(bf16x8, w); }
    } }
    if constexpr (DQK == 192) { if (b.qgain) {
#define UNPK(W, F) do { F[0] = __uint_as_float(W.x << 16); F[1] = __uint_as_float(W.x & 0xffff0000u); F[2] = __uint_as_float(W.y << 16); F[3] = __uint_as_float(W.y & 0xffff0000u); \
        F[4] = __uint_as_float(W.z << 16); F[5] = __uint_as_float(W.z & 0xffff0000u); F[6] = __uint_as_float(W.w << 16); F[7] = __uint_as_float(W.w & 0xffff0000u); } while (0)
        float ssq = 0.f;
#pragma unroll
        for (int d0 = 0; d0 < 12; ++d0) { const u32x4 w = __builtin_bit_cast(u32x4, qr[d0]); float f[8]; UNPK(w, f);
#pragma unroll
            for (int e = 0; e < 8; ++e) ssq += f[e] * f[e]; }
        { auto rr = __builtin_amdgcn_permlane32_swap(__float_as_uint(ssq), __float_as_uint(ssq), false, false); ssq = __uint_as_float(rr[0]) + __uint_as_float(rr[1]); }
        const float rn = rsqrtf(ssq * (1.f / 192.f) + 1e-6f) * (0.07216878364870323f * 1.4426950408889634f);
#pragma unroll
        for (int d0 = 0; d0 < 8; ++d0) { const u32x4 w = __builtin_bit_cast(u32x4, qr[d0]); float f[8]; UNPK(w, f);
            const f32x4v ga = *(const f32x4v*)(b.qgain + d0 * 16 + hi * 8), gb = *(const f32x4v*)(b.qgain + d0 * 16 + hi * 8 + 4);
#pragma unroll
            for (int e = 0; e < 8; ++e) f[e] *= rn * (e < 4 ? ga[e] : gb[e - 4]);
            u32x4 o_ = {cvtpk(f[0], f[1]), cvtpk(f[2], f[3]), cvtpk(f[4], f[5]), cvtpk(f[6], f[7])}; qr[d0] = __builtin_bit_cast(bf16x8, o_); asm volatile("" : "+v"(qr[d0])); }
#pragma unroll
        for (int t = 0; t < 2; ++t) { const u32x4 w1 = __builtin_bit_cast(u32x4, qr[8 + t]), w2 = __builtin_bit_cast(u32x4, qr[10 + t]); float f1[8], f2[8]; UNPK(w1, f1); UNPK(w2, f2);
            const f32x4v g1a = *(const f32x4v*)(b.qgain + (8 + t) * 16 + hi * 8), g1b = *(const f32x4v*)(b.qgain + (8 + t) * 16 + hi * 8 + 4);
            const f32x4v g2a = *(const f32x4v*)(b.qgain + (10 + t) * 16 + hi * 8), g2b = *(const f32x4v*)(b.qgain + (10 + t) * 16 + hi * 8 + 4);
            const float* tb = b.qtab + (size_t)(wid * QBLK + r32) * 64 + 16 * t + 8 * hi;
            const f32x4v ca = *(const f32x4v*)tb, cb = *(const f32x4v*)(tb + 4), sa = *(const f32x4v*)(tb + 32), sb = *(const f32x4v*)(tb + 36);
#pragma unroll
            for (int e = 0; e < 8; ++e) { const float cs = e < 4 ? ca[e] : cb[e - 4], sn = e < 4 ? sa[e] : sb[e - 4];
                const float x1 = f1[e] * rn * (e < 4 ? g1a[e] : g1b[e - 4]), x2 = f2[e] * rn * (e < 4 ? g2a[e] : g2b[e - 4]); f1[e] = x1 * cs - x2 * sn; f2[e] = x2 * cs + x1 * sn; }
            u32x4 o1 = {cvtpk(f1[0], f1[1]), cvtpk(f1[2], f1[3]), cvtpk(f1[4], f1[5]), cvtpk(f1[6], f1[7])}, o2 = {cvtpk(f2[0], f2[1]), cvtpk(f2[2], f2[3]), cvtpk(f2[4], f2[5]), cvtpk(f2[6], f2[7])};
            qr[8 + t] = __builtin_bit_cast(bf16x8, o1); qr[10 + t] = __builtin_bit_cast(bf16x8, o2); asm volatile("" : "+v"(qr[8 + t]), "+v"(qr[10 + t])); }
#undef UNPK
    } }
    unsigned ksrc[NKC], vsrc;
#pragma unroll
    for (int i = 0; i < NKC; ++i) { const int p = (wid + 8 * i) * 1024 + lane * 16; const int row = p / KROW, cc = ((p % KROW) >> 4) ^ (row & 7); ksrc[i] = (unsigned)(row * (int)b.ldk + cc * 8); }
    { const int sub = wid * 2 + (lane >> 5); const int kk = (sub >> 2) * 8 + ((lane & 31) >> 2); const int k = (kk & ~0xC) | ((kk & 4) << 1) | ((kk & 8) >> 1);
      vsrc = (unsigned)(k * (int)b.ldv + (sub & 3) * 32 + (lane & 3) * 8); }
    const int vb0 = (int)(uintptr_t)V_lds + v_rd_base(lane);
    ALAS unsigned char* ldsl = ldsp; const unsigned lds0 = (unsigned)(uintptr_t)ldsp;
#define ISSUE_K(t, bf) do { const bf16_t* kt_ = b.K + (size_t)(j_lo + (t)) * KVBLK * b.ldk; \
        _Pragma("unroll") for (int i = 0; i < NKC; ++i) glds16(kt_ + ksrc[i], (unsigned)__builtin_amdgcn_readfirstlane((int)(lds0 + 3 * SHM_V + (bf) * SHM_K + (wid + 8 * i) * 1024))); } while (0)
#define ISSUE_V(t, bf) do { const bf16_t* vt_ = b.V + (size_t)(j_lo + (t)) * KVBLK * b.ldv; \
        _Pragma("unroll") for (int i = 0; i < 2; ++i) glds16(vt_ + (size_t)i * 32 * b.ldv + vsrc, (unsigned)__builtin_amdgcn_readfirstlane((int)(lds0 + (bf) * SHM_V + (wid + 8 * i) * 1024))); } while (0)
#define WAIT_BAR(N) asm volatile("s_waitcnt vmcnt(%0) lgkmcnt(0)\n\ts_barrier" :: "n"(N) : "memory")
    float m_reg = -1e30f, l_reg = 0.f, alpha_c = 1.f; f32x16 o[4] = {}; f32x16 p0, p1;
    int kb4[4];
#pragma unroll
    for (int dd = 0; dd < 4; ++dd) kb4[dd] = KROW * r32 + ((dd * 32 + hi * 16) ^ ((r32 & 7) << 4));
#define ACT(s_) (!WSK || ((j_lo + (s_)) * KVBLK <= qlo + QBLK - 1 && (j_lo + (s_)) * KVBLK + KVBLK - 1 >= qlo - b.W + 1))
#define H1(s_) do { if (!ACT(s_)) break; qk_tile<ND, KROW>(p0, p1, (const ALAS char*)ldsl + 3 * SHM_V + ((s_) % 3) * SHM_K, kb4, qr); \
        const int kb_ = (j_lo + (s_)) * KVBLK; if (kb_ + KVBLK - 1 > qlo || kb_ <= qlo + QBLK - 1 - b.W) mask_tile(p0, p1, qm - kb_, (unsigned)b.W); \
        softmax_p1(p0, p1, m_reg, alpha_c); } while (0)
#define H2(s_) do { if (!ACT(s_)) break; const float alpha = alpha_c; bf16x8 pa0, pa1, pa2, pa3; softmax_p2(p0, p1, alpha, l_reg, pa0, pa1, pa2, pa3); \
        if (__any(alpha < 1.f)) { if (hi == 0) ws[32 + r32] = alpha; asm volatile("s_waitcnt lgkmcnt(0)" ::: "memory"); \
            _Pragma("unroll") for (int d_ = 0; d_ < 4; ++d_) _Pragma("unroll") for (int r = 0; r < 16; ++r) o[d_][r] *= ws[32 + crow(r, hi)]; } \
        SBAR(); pv_tile<(DQK == 128)>(o, vb0 + ((s_) % 3) * SHM_V, pa0, pa1, pa2, pa3); } while (0)
    ISSUE_K(0, 0); ISSUE_V(0, 0);
#pragma unroll
    for (int d0 = 0; d0 < ND; ++d0) asm volatile("" : "+v"(qr[d0]));
    if (NT > 1) { ISSUE_K(1, 1); ISSUE_V(1, 1); WAIT_BAR(NKC + 2); } else { WAIT_BAR(0); }
    if (wid < 4) {
        for (int s = 0; s < NT; ++s) { const bool more2 = s + 2 < NT;
            if (more2) ISSUE_K(s + 2, (s + 2) % 3);
            H1(s);
            if (more2) WAIT_BAR(2 * NKC + 2); else WAIT_BAR(0);
            if (more2) ISSUE_V(s + 2, (s + 2) % 3);
            H2(s);
            if (more2) WAIT_BAR(NKC + 4); else WAIT_BAR(0); }
        WAIT_BAR(0);
    } else {
        if (NT > 2) { ISSUE_K(2, 2); WAIT_BAR(2 * NKC + 2); } else { WAIT_BAR(0); }
        for (int s = 0; s < NT; ++s) { const bool more2 = s + 2 < NT, more3 = s + 3 < NT;
            if (more2) ISSUE_V(s + 2, (s + 2) % 3);
            H1(s);
            if (more2) WAIT_BAR(NKC + 4); else WAIT_BAR(0);
            if (more3) ISSUE_K(s + 3, s % 3);
            H2(s);
            if (more3) WAIT_BAR(2 * NKC + 2); else WAIT_BAR(0); }
    }
#undef H1
#undef ACT
#undef H2
#undef ISSUE_K
#undef ISSUE_V
#undef WAIT_BAR
#undef WAIT_BAR1
#undef WAIT_BAR2
    if (hi == 0) { ws[r32] = l_reg; if (b.mo) { b.mo[(size_t)(wid * QBLK + r32) * b.ldml] = m_reg; b.lo[(size_t)(wid * QBLK + r32) * b.ldml] = l_reg; } }
    asm volatile("s_waitcnt lgkmcnt(0)" ::: "memory");
    bf16_t* Ow = b.O + (size_t)(wid * QBLK) * b.ldo;
#pragma unroll
    for (int r = 0; r < 16; ++r) { const int orow = crow(r, hi); const float rl = __builtin_amdgcn_rcpf(ws[orow]);
#pragma unroll
        for (int d0 = 0; d0 < 4; ++d0) { const float v = o[d0][r] * rl; Ow[(size_t)orow * b.ldo + d0 * 32 + r32] = (bf16_t)(cvtpk(v, v) & 0xffffu); } }
    __syncthreads();
}
#undef SBAR
}

#define LAS __attribute__((address_space(3)))
typedef unsigned short bf16;
typedef unsigned v4u __attribute__((ext_vector_type(4)));
typedef unsigned v2u __attribute__((ext_vector_type(2)));
typedef float f32x4 __attribute__((ext_vector_type(4)));
constexpr int NWAVES = 8;
constexpr int BATCH = 2, SEQ = 8192, M = BATCH * SEQ, DM = 2048, DFF = 5632, DIN_T = 14336;
constexpr int NPH = 14;
constexpr size_t MiB = 1u << 20;
constexpr size_t WS_SS = 0;
constexpr size_t WS_BAR = 512 * 1024, WS_BAR_BYTES = 16384;
constexpr size_t WS_ML = 1 * MiB;
constexpr size_t WS_WGU = 8 * MiB, WS_WD = 52 * MiB, WS_WIN = 74 * MiB, WS_WUQ = 130 * MiB, WS_WUKV = WS_WUQ + 3 * MiB / 2, WS_WBRM = WS_WUKV + 1 * MiB,
                 WS_WBRD = WS_WBRM + 4 * MiB, WS_WO = WS_WBRD + 4 * MiB, WS_WPG = WS_WO + 8 * MiB, WS_WPP = WS_WPG + 8 * MiB;
constexpr size_t WS_XB = 158 * MiB;
constexpr size_t WS_ODIL = 222 * MiB;
constexpr size_t WS_PB = 254 * MiB;
constexpr size_t WS_R = 262 * MiB;
constexpr size_t WS_ROPE = 550 * MiB;
constexpr size_t WS_END = 554 * MiB;
constexpr size_t R_SMALL = WS_R, R_GATES = WS_R + 32 * MiB, R_Q = WS_R + 160 * MiB, R_K = WS_R + 208 * MiB, R_OMLA = WS_R + 256 * MiB, R_MERGED = R_Q, R_T = WS_R;
constexpr int RING_BYTES = 131072, LDS_BYTES = 147456;
constexpr float LOG2E = 1.4426950408889634f;

struct Args { const void* in[27]; float* out; unsigned char* ws; int ph_lo, ph_hi; };

__device__ __forceinline__ float wave_sum(float v) {
#pragma unroll
    for (int o = 1; o < 64; o <<= 1) v += __shfl_xor(v, o);
    return v;
}
__device__ __forceinline__ unsigned f2bf(float f) { unsigned u = __builtin_bit_cast(unsigned, f); return (u + 0x7fffu + ((u >> 16) & 1u)) >> 16; }
__device__ __forceinline__ unsigned pk2(float lo, float hi) { return f2bf(lo) | (f2bf(hi) << 16); }
__device__ __forceinline__ float bflo(unsigned w) { return __uint_as_float(w << 16); }
__device__ __forceinline__ float bfhi(unsigned w) { return __uint_as_float(w & 0xffff0000u); }
template <int MAP> __device__ __forceinline__ int drow0(int n0) {
    if (MAP == 1) return (n0 >> 7) * 256 + ((n0 & 127) >> 5) * 64;
    if (MAP == 2) return (n0 >> 7) * 256 + ((n0 & 127) >> 5) * 64 + 32;
    if (MAP == 3) return n0 < 832 ? 9216 + n0 : (n0 < 10048 ? n0 - 832 : 10240 + (n0 - 10048));
    return n0;
}
template <int MAP> __device__ __forceinline__ void xpose_item(const float* W, int K, int N, const float* gain, bf16* WT, LAS float* scr, int item, int lane) {
    const int nblk = N / 32, kb = item / nblk, nb = item % nblk, k0 = 64 * kb, n0 = 32 * nb;
    float tv[32];
#pragma unroll
    for (int i = 0; i < 32; ++i) { const int kk = 2 * i + (lane >> 5); tv[i] = W[(size_t)(k0 + kk) * N + n0 + (lane & 31)]; }
#pragma unroll
    for (int i = 0; i < 32; ++i) { const int kk = 2 * i + (lane >> 5); const float gv = gain ? gain[k0 + kk] : 1.f; scr[kk * 33 + (lane & 31)] = tv[i] * gv; }
    asm volatile("s_waitcnt lgkmcnt(0)" ::: "memory");
    const int c = lane & 7, d0 = drow0<MAP>(n0);
#pragma unroll
    for (int j = 0; j < 4; ++j) { const int n = (lane >> 3) + 8 * j; const LAS float* s = scr + (8 * c) * 33 + n;
        v4u o; o.x = pk2(s[0 * 33], s[1 * 33]); o.y = pk2(s[2 * 33], s[3 * 33]); o.z = pk2(s[4 * 33], s[5 * 33]); o.w = pk2(s[6 * 33], s[7 * 33]);
        *(v4u*)(WT + (size_t)(d0 + n) * K + k0 + 8 * c) = o; }
    asm volatile("s_waitcnt lgkmcnt(0)" ::: "memory");
}
struct XJob { const float* W; const float* gain; bf16* WT; int K, N, map; };
__device__ __forceinline__ void xpose_run(const XJob& j, LAS float* scr, int gw, int NGW, int lane, int& base) {
    const int items = (j.K / 64) * (j.N / 32);
    int first = gw - (base % NGW); if (first < 0) first += NGW;
    for (int it = first; it < items; it += NGW) {
        if (j.map == 0) xpose_item<0>(j.W, j.K, j.N, j.gain, j.WT, scr, it, lane);
        else if (j.map == 1) xpose_item<1>(j.W, j.K, j.N, j.gain, j.WT, scr, it, lane);
        else if (j.map == 2) xpose_item<2>(j.W, j.K, j.N, j.gain, j.WT, scr, it, lane);
        else xpose_item<3>(j.W, j.K, j.N, j.gain, j.WT, scr, it, lane);
    }
    base += items;
}
__device__ __forceinline__ void sincos_rev(float ang, float& s, float& c) {
    double rv = (double)ang * 0.15915494309189535; rv -= __builtin_rint(rv); const float f = (float)rv;
    s = __builtin_amdgcn_sinf(f); c = __builtin_amdgcn_cosf(f);
}

typedef unsigned short bf16_dummy_t;
#define XB_TMO      128
#define XB_XCNT(j)  (256  + 64 * (j))
#define XB_XSUB(j)  (1280 + 64 * (j))
#define XB_XGEN(j)  (2304 + 64 * (j))
#define XB_TOP      3328
#define XB_TOPGEN   3392
#define XCD_BAR_WORDS 3456
#define XB_SPIN_CAP (1u << 18)

__device__ __forceinline__ unsigned xb_ld(unsigned* p)              { return __hip_atomic_load(p, __ATOMIC_RELAXED, __HIP_MEMORY_SCOPE_AGENT); }
__device__ __forceinline__ unsigned xb_add(unsigned* p, unsigned v) { return __hip_atomic_fetch_add(p, v, __ATOMIC_RELAXED, __HIP_MEMORY_SCOPE_AGENT); }
__device__ __forceinline__ unsigned xb_xcc_id() { return (unsigned)__builtin_amdgcn_s_getreg((3 << 11) | 20) & 0xFu; }
#define XB_SPIN(cond, bar) do { unsigned _sp = 0; while (cond) { __builtin_amdgcn_s_sleep(1); \
    if ((++_sp & 255u) == 0u) { if (xb_ld(&(bar)[XB_TMO])) break; if (_sp > XB_SPIN_CAP) { atomicAdd(&(bar)[XB_TMO], 1u); break; } } } } while (0)

struct XcdBarrier {
    unsigned* bar; unsigned x;
    volatile LAS unsigned* st;
};

__device__ __forceinline__ XcdBarrier xcd_barrier_post(unsigned* bar, volatile LAS unsigned* st) {
    XcdBarrier b; b.bar = bar; b.x = xb_xcc_id(); b.st = st;
    if (threadIdx.x == 0) (void)xb_add(&bar[XB_XCNT(b.x)], 1u);
    return b;
}
__device__ __forceinline__ void xcd_barrier_complete(unsigned* bar, unsigned x, unsigned& nloc, unsigned& nx) {
    const unsigned G = gridDim.x * gridDim.y * gridDim.z;
    unsigned sum, cnt, mine, sp = 0u;
    for (;;) {
        sum = 0u; cnt = 0u; mine = 0u;
#pragma unroll
        for (unsigned j = 0; j < 16; ++j) { const unsigned c = xb_ld(&bar[XB_XCNT(j)]); sum += c; cnt += (c > 0u) ? 1u : 0u; mine = (j == x) ? c : mine; }
        if (sum == G) break;
        __builtin_amdgcn_s_sleep(1);
        if ((++sp & 255u) == 0u) { if (xb_ld(&bar[XB_TMO])) break; if (sp > XB_SPIN_CAP) { atomicAdd(&bar[XB_TMO], 1u); break; } }
    }
    nloc = mine > 0u ? mine : 1u; nx = cnt > 0u ? cnt : 1u;
}

__device__ __forceinline__ void xcd_barrier(const XcdBarrier& b) {
    asm volatile("s_waitcnt vmcnt(0)" ::: "memory");
    __syncthreads();
    if (threadIdx.x == 0) {
        unsigned* bar = b.bar;
        __builtin_amdgcn_s_waitcnt(0);
        unsigned nloc = b.st[0], nx = b.st[1];
        if (nloc == 0u) { xcd_barrier_complete(bar, b.x, nloc, nx); b.st[0] = nloc; b.st[1] = nx; }
        const unsigned old = xb_add(&bar[XB_XSUB(b.x)], 1u);
        const unsigned gen = old / nloc;
        if (old + 1u == (gen + 1u) * nloc) {
            __builtin_amdgcn_fence(__ATOMIC_RELEASE, "agent");
            asm volatile("s_waitcnt vmcnt(0)" ::: "memory");
            const unsigned og = xb_add(&bar[XB_TOP], 1u);
            const unsigned tg = og / nx;
            if (og + 1u == (tg + 1u) * nx) xb_add(&bar[XB_TOPGEN], 1u);
            else XB_SPIN(xb_ld(&bar[XB_TOPGEN]) == tg, bar);
            __builtin_amdgcn_fence(__ATOMIC_ACQUIRE, "agent");
            xb_add(&bar[XB_XGEN(b.x)], 1u);
            asm volatile("s_waitcnt vmcnt(0)" ::: "memory");
        } else {
            XB_SPIN(xb_ld(&bar[XB_XGEN(b.x)]) == gen, bar);
            __builtin_amdgcn_fence(__ATOMIC_ACQUIRE, "agent");
            asm volatile("s_waitcnt vmcnt(0)" ::: "memory");
        }
    }
    __syncthreads();
}

__device__ __forceinline__ void stagger(int bx, unsigned ticks) {
    const unsigned long long t0 = __builtin_amdgcn_s_memrealtime(); const unsigned long long dl = (unsigned long long)((bx >> 3) & 3) * ticks;
    while (__builtin_amdgcn_s_memrealtime() - t0 < dl) __builtin_amdgcn_s_sleep(8);
}
__global__ void __launch_bounds__(NWAVES * 64, 2) mk_fwd(Args args) {
    extern __shared__ __attribute__((aligned(16))) unsigned char lds[];
    const int wave = __builtin_amdgcn_readfirstlane((int)threadIdx.x >> 6);
#define tid ((int)threadIdx.x)
#define lane ((int)threadIdx.x & 63)
    const int G = gridDim.x, bx = blockIdx.x;
    const int gw = bx * NWAVES + wave, NGW = G * NWAVES;
    unsigned char* ws = args.ws;
#define xin ((const float*)args.in[0])
#define pin ((const float*)args.in[1])
#define positions ((const int*)args.in[2])
#define g_ffn1 ((const float*)args.in[3])
#define w1_gate ((const float*)args.in[4])
#define w1_up ((const float*)args.in[5])
#define w1_down ((const float*)args.in[6])
#define g_mix ((const float*)args.in[7])
#define w_in ((const float*)args.in[8])
#define g_cq ((const float*)args.in[9])
#define w_uq ((const float*)args.in[10])
#define g_ckv ((const float*)args.in[11])
#define w_ukv ((const float*)args.in[12])
#define g_q_mla ((const float*)args.in[13])
#define g_k_mla ((const float*)args.in[14])
#define g_q_dil ((const float*)args.in[15])
#define g_k_dil ((const float*)args.in[16])
#define w_br_mla ((const float*)args.in[17])
#define w_br_dil ((const float*)args.in[18])
#define w_o ((const float*)args.in[19])
#define g_ffn2 ((const float*)args.in[20])
#define w2_gate ((const float*)args.in[21])
#define w2_up ((const float*)args.in[22])
#define w2_down ((const float*)args.in[23])
#define g_ple ((const float*)args.in[24])
#define w_ple_gate ((const float*)args.in[25])
#define w_ple_proj ((const float*)args.in[26])
    float* out = args.out;
    float* ss0 = (float*)(ws + WS_SS); float* ss1 = ss0 + M; float* ss2 = ss0 + 2 * M; float* ss3 = ss0 + 3 * M; float* ss_cq = ss0 + 4 * M; float* ss_ckv = ss0 + 5 * M;
    float* mlm = (float*)(ws + WS_ML); float* mll = mlm + 3 * M * 8;
    bf16* Wgu = (bf16*)(ws + WS_WGU); bf16* Wd = (bf16*)(ws + WS_WD); bf16* Win = (bf16*)(ws + WS_WIN); bf16* Wuq = (bf16*)(ws + WS_WUQ); bf16* Wukv = (bf16*)(ws + WS_WUKV);
    bf16* Wbrm = (bf16*)(ws + WS_WBRM); bf16* Wbrd = (bf16*)(ws + WS_WBRD); bf16* Wo = (bf16*)(ws + WS_WO); bf16* Wpg = (bf16*)(ws + WS_WPG); bf16* Wpp = (bf16*)(ws + WS_WPP);
    bf16* xb = (bf16*)(ws + WS_XB); bf16* kvraw = (bf16*)out;     bf16* odil = (bf16*)(ws + WS_ODIL); bf16* pb = (bf16*)(ws + WS_PB);
    bf16* act = (bf16*)(ws + WS_R); bf16* projd = (bf16*)(ws + WS_R); bf16* smallb = (bf16*)(ws + R_SMALL); bf16* gates = (bf16*)(ws + R_GATES);
    bf16* Qm = (bf16*)(ws + R_Q); bf16* Km = (bf16*)(ws + R_K); bf16* omla = (bf16*)(ws + R_OMLA); bf16* merged = (bf16*)(ws + R_MERGED); bf16* Tb = (bf16*)(ws + R_T);
    LAS unsigned char* ldsl = (LAS unsigned char*)lds;
    LAS float* scr = (LAS float*)(ldsl + wave * 16384);
    const int lo = args.ph_lo, hi = args.ph_hi;
#define SPLIT_LVL 0
#define SPLIT_SCR out
    volatile LAS unsigned* bst = (volatile LAS unsigned*)(ldsl + RING_BYTES);
    if (threadIdx.x < 2) bst[threadIdx.x] = 0u;
    __syncthreads();
    XcdBarrier gbar; gbar.bar = (unsigned*)(ws + WS_BAR); gbar.x = 0; gbar.st = bst;
    if (hi - lo > 1) gbar = xcd_barrier_post((unsigned*)(ws + WS_BAR), bst);
    if (lo < 0) cg::this_grid().sync();
#ifndef PH_MASK
#define PH_MASK 0xffff
#endif
#define IN(k) ((((PH_MASK) >> (k)) & 1) && lo <= (k) && (k) < hi)
#define SEAM(k) do { if (IN(k) && IN((k) + 1)) { xcd_barrier(gbar); } } while (0)

    if (IN(0)) {
        int base = 0;
        { XJob j{w1_gate, g_ffn1, Wgu, DM, DFF, 1}; xpose_run(j, scr, gw, NGW, lane, base); }
        { XJob j{w1_up, g_ffn1, Wgu, DM, DFF, 2}; xpose_run(j, scr, gw, NGW, lane, base); }
        { XJob j{w1_down, nullptr, Wd, DFF, DM, 0}; xpose_run(j, scr, gw, NGW, lane, base); }
        { XJob j{w_in, g_mix, Win, DM, 14144, 3}; xpose_run(j, scr, gw, NGW, lane, base); }
        { XJob j{w_uq, g_cq, Wuq, 512, 1536, 0}; xpose_run(j, scr, gw, NGW, lane, base); }
        { XJob j{w_ukv, g_ckv, Wukv, 256, 2048, 0}; xpose_run(j, scr, gw, NGW, lane, base); }
        { XJob j{w_br_mla, nullptr, Wbrm, 1024, DM, 0}; xpose_run(j, scr, gw, NGW, lane, base); }
        { XJob j{w_br_dil, nullptr, Wbrd, 1024, DM, 0}; xpose_run(j, scr, gw, NGW, lane, base); }
        { XJob j{w_o, nullptr, Wo, DM, DM, 0}; xpose_run(j, scr, gw, NGW, lane, base); }
        { XJob j{w_ple_gate, g_ple, Wpg, DM, DM, 0}; xpose_run(j, scr, gw, NGW, lane, base); }
        { XJob j{w_ple_proj, nullptr, Wpp, 256, DM, 0}; xpose_run(j, scr, gw, NGW, lane, base); }
        for (int m = gw; m < M; m += NGW) {
            const f32x4* xr = (const f32x4*)(xin + (size_t)m * DM) + lane; f32x4 v[8]; float s = 0.f;
#pragma unroll
            for (int j = 0; j < 8; ++j) { v[j] = xr[64 * j]; s += (v[j].x * v[j].x + v[j].y * v[j].y) + (v[j].z * v[j].z + v[j].w * v[j].w); }
            s = wave_sum(s); if (lane == 0) ss0[m] = s;
            v2u* o8 = (v2u*)(xb + (size_t)m * DM) + lane;
#pragma unroll
            for (int j = 0; j < 8; ++j) o8[64 * j] = (v2u){pk2(v[j].x, v[j].y), pk2(v[j].z, v[j].w)};
            const f32x4 pv = *((const f32x4*)(pin + (size_t)m * 256) + lane);
            *((v2u*)(pb + (size_t)m * 256) + lane) = (v2u){pk2(pv.x, pv.y), pk2(pv.z, pv.w)};
        }
        for (int i = bx * 512 + tid; i < 5 * M; i += G * 512) ss1[i] = 0.f;
    }
    SEAM(0);
    if (IN(1)) {
        pg8::Gemm g{xb, Wgu, M, 2 * DFF, DM, DM, DM, nullptr, nullptr}; pg8::SplitOrder S; S.init(M, 2 * DFF, DM, G, bx, SPLIT_LVL, SPLIT_SCR);
        pg8::EpiSwiGLU E{act, DFF, ss0, 1.f / DM};
        pg8::gemm_phase<pg8::EpiSwiGLU, pg8::SplitOrder, true, true>(ldsl, g, S, E);
    }
    SEAM(1);
    if (IN(2)) {
        pg8::Gemm g{act, Wd, M, DM, DFF, DFF, DFF, nullptr, nullptr}; pg8::SplitOrder S; S.init(M, DM, DFF, G, bx, 0, SPLIT_SCR);
        pg8::EpiResid<false> E{xin, xb, ss1, 0.5f};
        pg8::gemm_phase<pg8::EpiResid<false>, pg8::SplitOrder, true, true>(ldsl, g, S, E);
    }
    SEAM(2);
    if (IN(3)) {
        pg8::Gemm g{xb, Win, M, 9216, DM, DM, DM, nullptr, nullptr}; pg8::SplitOrder S; S.init(M, 9216, DM, G, bx, SPLIT_LVL, SPLIT_SCR);
        pg8::EpiScale<0> E{projd, 9216, ss1, 1.f / DM};
        pg8::gemm_phase<pg8::EpiScale<0>, pg8::SplitOrder, true, true>(ldsl, g, S, E);
    }
    SEAM(3);
    if (IN(4)) {
        int base = 0;
        { XJob j{w2_gate, g_ffn2, Wgu, DM, DFF, 1}; xpose_run(j, scr, gw, NGW, lane, base); }
        { XJob j{w2_up, g_ffn2, Wgu, DM, DFF, 2}; xpose_run(j, scr, gw, NGW, lane, base); }
        { XJob j{w2_down, nullptr, Wd, DFF, DM, 0}; xpose_run(j, scr, gw, NGW, lane, base); }
        const int i16 = lane & 15, vsel = lane >> 4;
        for (int tok = gw; tok < M; tok += NGW) {
            const float pos = (float)positions[tok];
            float cs[8], sn[8];
#pragma unroll
            for (int e = 0; e < 8; ++e) { const int jj = 8 * (i16 & 1) + e; const float inv = exp2f(-(float)jj * (1.f / 16.f) * 18.931568569324174f); sincos_rev(pos * inv, sn[e], cs[e]); }
            bf16* tp = projd + (size_t)tok * 9216 + vsel * 128 + i16 * 8;
            v4u wv[12];
#pragma unroll
            for (int c = 0; c < 12; ++c) if ((c >> 1) & 1) wv[c] = *(const v4u*)(tp + (c >> 2) * 3072 + ((c >> 1) & 1) * 1024 + (c & 1) * 512);
#pragma unroll
            for (int c = 0; c < 12; ++c) { const int gi = c >> 2, qk = (c >> 1) & 1; if (!qk) continue;
                const float* gain = (qk ? g_k_dil : g_q_dil) + gi * 128 + i16 * 8;
                const f32x4 ga = *(const f32x4*)gain, gb = *(const f32x4*)(gain + 4);
                const float gsc = qk ? 1.f : 0.08838834764831845f * LOG2E;
                const v4u w = wv[c]; float v[8] = {bflo(w.x), bfhi(w.x), bflo(w.y), bfhi(w.y), bflo(w.z), bfhi(w.z), bflo(w.w), bfhi(w.w)};
                float s = 0.f;
#pragma unroll
                for (int e = 0; e < 8; ++e) s += v[e] * v[e];
                s += __shfl_xor(s, 1); s += __shfl_xor(s, 2); s += __shfl_xor(s, 4); s += __shfl_xor(s, 8);
                const float r = rsqrtf(s * (1.f / 128.f) + 1e-6f);
#pragma unroll
                for (int e = 0; e < 8; ++e) v[e] *= r * (e < 4 ? ga[e] : gb[e - 4]);
#pragma unroll
                for (int e = 0; e < 8; ++e) { const float pr = __shfl_xor(v[e], 2); if (i16 < 4) v[e] = (i16 < 2) ? v[e] * cs[e] - pr * sn[e] : v[e] * cs[e] + pr * sn[e]; }
                v4u o; o.x = pk2(v[0] * gsc, v[1] * gsc); o.y = pk2(v[2] * gsc, v[3] * gsc); o.z = pk2(v[4] * gsc, v[5] * gsc); o.w = pk2(v[6] * gsc, v[7] * gsc);
                *(v4u*)(tp + (c >> 2) * 3072 + ((c >> 1) & 1) * 1024 + (c & 1) * 512) = o; }
        }
    }
    SEAM(4);
    if (IN(5)) {
        for (int it = bx; it < 1536; it += G) {
            const int gi = it / 512, r1 = it % 512, bb = r1 / 256, r2 = r1 % 256, h = r2 / 32, nb = r2 % 32;
            const int dil = gi == 0 ? 1 : (gi == 1 ? 4 : 16), Lg = SEQ / dil, bpp = Lg / 256, ph = nb / bpp, ib = nb % bpp;
            bf16* seq0 = projd + ((size_t)bb * SEQ + ph) * 9216 + gi * 3072 + h * 128;
            att::Blk b; b.ldq = b.ldk = b.ldv = b.ldo = (long)dil * 9216; b.P0 = ib * 256; b.skv = Lg; b.W = 129;
            b.Q = seq0 + (size_t)b.P0 * b.ldq; b.O = seq0 + (size_t)b.P0 * b.ldq; b.K = seq0 + 1024; b.V = seq0 + 2048;
            const size_t tok0 = (size_t)bb * SEQ + ph + (size_t)dil * b.P0;
            b.mo = mlm + ((size_t)gi * M + tok0) * 8 + h; b.lo = mll + ((size_t)gi * M + tok0) * 8 + h; b.ldml = (long)dil * 8;
            b.qgain = g_q_dil + gi * 128; b.qpos = positions + tok0; b.qpstride = dil; b.qtab = nullptr;
            att::attn_block<128>(b, ldsl);
        }
    }
    SEAM(5);
    if (IN(6)) {
        for (int i = bx * 512 + tid; i < 2 * M; i += G * 512) ss_cq[i] = 0.f;
        for (int i = bx * 512 + tid; i < M * 8 * 16; i += G * 512) { const int tok = i >> 7, h = (i >> 4) & 7, c = i & 15;
            float mg[3], lg[3];
#pragma unroll
            for (int gi = 0; gi < 3; ++gi) { mg[gi] = mlm[((size_t)gi * M + tok) * 8 + h]; lg[gi] = mll[((size_t)gi * M + tok) * 8 + h]; }
            const float mx = fmaxf(fmaxf(mg[0], mg[1]), mg[2]); float wsum = 0.f, wg[3];
#pragma unroll
            for (int gi = 0; gi < 3; ++gi) { wg[gi] = lg[gi] * exp2f(mg[gi] - mx); wsum += wg[gi]; }
            const float iw = 1.f / wsum; float a[8] = {0.f, 0.f, 0.f, 0.f, 0.f, 0.f, 0.f, 0.f};
#pragma unroll
            for (int gi = 0; gi < 3; ++gi) { const v4u w = *(const v4u*)(projd + (size_t)tok * 9216 + gi * 3072 + h * 128 + c * 8); const float f = wg[gi] * iw;
                a[0] += f * bflo(w.x); a[1] += f * bfhi(w.x); a[2] += f * bflo(w.y); a[3] += f * bfhi(w.y); a[4] += f * bflo(w.z); a[5] += f * bfhi(w.z); a[6] += f * bflo(w.w); a[7] += f * bfhi(w.w); }
            v4u o; o.x = pk2(a[0], a[1]); o.y = pk2(a[2], a[3]); o.z = pk2(a[4], a[5]); o.w = pk2(a[6], a[7]);
            *(v4u*)(odil + (size_t)tok * 1024 + h * 128 + c * 8) = o; }
    }
    SEAM(6);
    if (IN(7)) {
        pg8::Gemm g{xb, Win + (size_t)9216 * DM, M, 5120, DM, DM, DM, nullptr, nullptr}; pg8::SplitOrder S; S.init(M, 5120, DM, G, bx, 0, SPLIT_SCR);
        pg8::EpiP3b E{smallb, gates, ss1, ss_cq, ss_ckv};
        pg8::gemm_phase<pg8::EpiP3b, pg8::SplitOrder, true, true>(ldsl, g, S, E);
    }
    SEAM(7);
    if (IN(8)) {
        { pg8::Gemm g{smallb, Wuq, M, 1536, 512, 1024, 512, nullptr, nullptr}; pg8::SplitOrder S; S.init(M, 1536, 512, G, bx, 0, nullptr);
          pg8::EpiScale<0> E{Qm, 1536, ss_cq, 1.f / 512.f};
          pg8::gemm_phase<pg8::EpiScale<0>, pg8::SplitOrder, true, true>(ldsl, g, S, E); }
        { pg8::Gemm g{smallb + 512, Wukv, M, 2048, 256, 1024, 256, nullptr, nullptr}; pg8::SplitOrder S; S.init(M, 2048, 256, G, bx, 0, nullptr);
          pg8::EpiScale<0> E{kvraw, 2048, ss_ckv, 1.f / 256.f};
          pg8::gemm_phase<pg8::EpiScale<0>, pg8::SplitOrder, true, true>(ldsl, g, S, E); }
    }
    SEAM(8);
    if (IN(9)) {
        const int jj = lane & 31; const float inv = exp2f(-(float)jj * (1.f / 32.f) * 18.931568569324174f);
        const float gqn0 = g_q_mla[2 * lane], gqn1 = g_q_mla[2 * lane + 1], gqr = g_q_mla[128 + lane];
        const float gkn0 = g_k_mla[2 * lane], gkn1 = g_k_mla[2 * lane + 1], gkr = g_k_mla[128 + lane];
        const float qsc = 0.07216878364870323f * LOG2E;
        for (int tok = gw; tok < M; tok += NGW) {
            float sn, cs; sincos_rev((float)positions[tok] * inv, sn, cs);
            ((float*)(ws + WS_ROPE))[(size_t)tok * 64 + lane] = lane < 32 ? cs : sn;
            const float krv = bflo((unsigned)smallb[(size_t)tok * 1024 + 768 + lane]);
            const bf16* kt = kvraw + (size_t)tok * 2048; bf16* ko = Km + (size_t)tok * 1536;
            unsigned kw[8];
#pragma unroll
            for (int h = 0; h < 8; ++h) kw[h] = *(const unsigned*)(kt + h * 256 + 2 * lane);
#pragma unroll
            for (int h = 0; h < 8; ++h) {
                { float a0 = bflo(kw[h]), a1 = bfhi(kw[h]), ar = krv;
                  const float s = wave_sum(a0 * a0 + a1 * a1 + ar * ar); const float r = rsqrtf(s * (1.f / 192.f) + 1e-6f);
                  a0 *= r * gkn0; a1 *= r * gkn1; ar *= r * gkr; const float pr = __shfl_xor(ar, 32); ar = lane < 32 ? ar * cs - pr * sn : ar * cs + pr * sn;
                  *(unsigned*)(ko + h * 192 + 2 * lane) = pk2(a0, a1); ko[h * 192 + 128 + lane] = (bf16)f2bf(ar); }
            }
        }
    }
    SEAM(9);
    if (IN(10)) {
        for (int it0 = bx; it0 < 256; it0 += G) { const int it = (G == 256) ? ((((it0 & 7) * 2 + (it0 >> 7)) << 4) | ((it0 >> 3) & 15)) : it0;
            const int bh = it >> 4, xq = it & 15, bb = bh >> 3, h = bh & 7;
            for (int ps = 0; ps < 2; ++ps) { const int qb = ps ? 31 - xq : xq;
                att::Blk b; b.ldq = 1536; b.ldk = 1536; b.ldv = 2048; b.ldo = 1024; b.P0 = qb * 256; b.skv = SEQ; b.W = 1 << 30;
                b.Q = Qm + ((size_t)bb * SEQ + b.P0) * 1536 + h * 192; b.K = Km + (size_t)bb * SEQ * 1536 + h * 192; b.V = kvraw + (size_t)bb * SEQ * 2048 + h * 256 + 128;
                b.O = omla + ((size_t)bb * SEQ + b.P0) * 1024 + h * 128; b.mo = nullptr; b.lo = nullptr; b.ldml = 0; b.qgain = g_q_mla; b.qpos = nullptr; b.qpstride = 1; b.qtab = (const float*)(ws + WS_ROPE) + ((size_t)bb * SEQ + b.P0) * 64;
                att::attn_block<192>(b, ldsl); } }
    }
    SEAM(10);
    if (IN(11)) {
        pg8::Gemm g{omla, Wbrm, M, DM, 1024, 1024, 1024, odil, Wbrd}; pg8::ChainOrder S; S.init(M, DM, 1024, G, bx);
        pg8::EpiBrChain E{merged, gates};
        pg8::gemm_phase<pg8::EpiBrChain, pg8::ChainOrder, true, true>(ldsl, g, S, E);
    }
    SEAM(11);
    if (IN(12)) {
        pg8::Gemm g{merged, Wo, M, DM, DM, DM, DM, nullptr, nullptr}; pg8::SplitOrder S; S.init(M, DM, DM, G, bx, 0, SPLIT_SCR);
        pg8::EpiResid<true> E{nullptr, xb, ss2, 1.f};
        pg8::gemm_phase<pg8::EpiResid<true>, pg8::SplitOrder, true, true>(ldsl, g, S, E);
    }
    SEAM(12);
    if (IN(13)) {
        pg8::Gemm g{xb, Wgu, M, 2 * DFF, DM, DM, DM, nullptr, nullptr}; pg8::SplitOrder S; S.init(M, 2 * DFF, DM, G, bx, SPLIT_LVL, SPLIT_SCR);
        pg8::EpiSwiGLU E{act, DFF, ss2, 1.f / DM};
        pg8::gemm_phase<pg8::EpiSwiGLU, pg8::SplitOrder, true, true>(ldsl, g, S, E);
    }
    SEAM(13);
    if (IN(14)) {
        pg8::Gemm g{act, Wd, M, DM, DFF, DFF, DFF, nullptr, nullptr}; pg8::SplitOrder S; S.init(M, DM, DFF, G, bx, 0, SPLIT_SCR);
        pg8::EpiResid<true> E{nullptr, xb, ss3, 0.5f};
        pg8::gemm_phase<pg8::EpiResid<true>, pg8::SplitOrder, true, true>(ldsl, g, S, E);
    }
    SEAM(14);
    if (IN(15)) {
        { pg8::Gemm g{pb, Wpp, M, DM, 256, 256, 256, nullptr, nullptr}; pg8::SplitOrder S; S.init(M, DM, 256, G, bx, 0, (float*)(ws + WS_R + 64 * MiB));
          pg8::EpiScale<0> E{Tb, DM, nullptr, 0.f};
          pg8::gemm_phase<pg8::EpiScale<0>, pg8::SplitOrder, true, true>(ldsl, g, S, E); }
        { pg8::Gemm g{xb, Wpg, M, DM, DM, DM, DM, nullptr, nullptr}; pg8::SplitOrder S; S.init(M, DM, DM, G, bx, 0, (float*)(ws + WS_R + 64 * MiB));
          pg8::EpiPle E{out, xb, Tb, ss3};
          pg8::gemm_phase<pg8::EpiPle, pg8::SplitOrder, true, true>(ldsl, g, S, E); }
    }
#undef IN
#undef SEAM
#undef xin
#undef pin
#undef positions
#undef g_ffn1
#undef w1_gate
#undef w1_up
#undef w1_down
#undef g_mix
#undef w_in
#undef g_cq
#undef w_uq
#undef g_ckv
#undef w_ukv
#undef g_q_mla
#undef g_k_mla
#undef g_q_dil
#undef g_k_dil
#undef w_br_mla
#undef w_br_dil
#undef w_o
#undef g_ffn2
#undef w2_gate
#undef w2_up
#undef w2_down
#undef g_ple
#undef w_ple_gate
#undef w_ple_proj
#undef SPLIT_LVL
#undef SPLIT_SCR
#undef tid
#undef lane
}
constexpr int N_PHASES = 16;

extern "C" void kernel_launch(void* const* d_in, const int* in_sizes, int n_in, void* d_out, int out_size, void* d_ws, size_t ws_size, hipStream_t stream) {
    static int grid = 0;
    if (grid == 0) {
        if (n_in != 27 || out_size != M * DM || ws_size < WS_END) { fprintf(stderr, "kernel_launch: unexpected shapes / workspace (n_in %d out %d ws %zu)\n", n_in, out_size, ws_size); grid = -1; return; }
        int dev = 0, cus = 0, per_cu = 0;
        (void)hipGetDevice(&dev); (void)hipDeviceGetAttribute(&cus, hipDeviceAttributeMultiprocessorCount, dev);
        if (hipFuncSetAttribute((const void*)mk_fwd, hipFuncAttributeMaxDynamicSharedMemorySize, LDS_BYTES) != hipSuccess) { fprintf(stderr, "hipFuncSetAttribute failed\n"); grid = -1; return; }
        if (hipOccupancyMaxActiveBlocksPerMultiprocessor(&per_cu, (const void*)mk_fwd, NWAVES * 64, LDS_BYTES) != hipSuccess || per_cu < 1) { fprintf(stderr, "occupancy query: %d\n", per_cu); per_cu = 1; }
        (void)hipGetLastError();
        grid = cus > 0 ? cus : 256;
    }
    if (grid < 0) return;
    (void)hipMemsetAsync((unsigned char*)d_ws + WS_BAR, 0, WS_BAR_BYTES, stream);
    Args a{};
    for (int i = 0; i < 27; ++i) a.in[i] = d_in[i];
    a.out = (float*)d_out; a.ws = (unsigned char*)d_ws;
#if MK_PER_PHASE
#ifndef DUP_LO
#define DUP_LO 0
#define DUP_HI 0
#define DUP_N 0
#endif
    for (int p = 0; p < N_PHASES; ++p) { a.ph_lo = p; a.ph_hi = p + 1; hipLaunchKernelGGL(mk_fwd, dim3(grid), dim3(NWAVES * 64), LDS_BYTES, stream, a);
        if (p == DUP_HI - 1) for (int rep = 0; rep < DUP_N; ++rep) for (int q = DUP_LO; q < DUP_HI; ++q) { a.ph_lo = q; a.ph_hi = q + 1; hipLaunchKernelGGL(mk_fwd, dim3(grid), dim3(NWAVES * 64), LDS_BYTES, stream, a); } }
#else
    a.ph_lo = 0; a.ph_hi = N_PHASES;
    void* kargs[] = {&a};
    hipError_t e = hipLaunchCooperativeKernel((const void*)mk_fwd, dim3(grid), dim3(NWAVES * 64), kargs, LDS_BYTES, stream);
    if (e != hipSuccess) fprintf(stderr, "cooperative launch failed: %s (grid %d)\n", hipGetErrorString(e), grid);
#endif
}
```
